# Optimizing an MI355X kernel written in HIP

```python
import math
import jax, jax.numpy as jnp
from jax import lax
import numpy as np

D_MODEL = 1024
BATCH = 16
SEQ = 4096
DEPTH = 2

PLE_DIM = 256
EPS = 1e-6
ROPE_THETA = 500000.0
RET_THETA = 10000.0
BLOCK_Q = 128
CHUNK = 128
N_BRANCH = 4

LRU_WIDTH = D_MODEL
LRU_BLOCKS = 16
LRU_BLOCK = LRU_WIDTH // LRU_BLOCKS
CONV_WIDTH = 4
LRU_C = 8.0
DIFF_HEADS = 8
DIFF_DH = D_MODEL // (2 * DIFF_HEADS)
DIFF_ROT = DIFF_DH // 4
MLA_HEADS = 8
MLA_NOPE = 128
MLA_ROPE = 64
MLA_V = 128
MLA_Q_LORA = 3 * D_MODEL // 8
MLA_KV_LORA = D_MODEL // 4
RET_HEADS = 8
RET_DK = 64
RET_DV = 128
D_FF = 4 * D_MODEL

IN_SIZES = (LRU_WIDTH, LRU_WIDTH,
            DIFF_HEADS * 2 * DIFF_DH, DIFF_HEADS * 2 * DIFF_DH, DIFF_HEADS * 2 * DIFF_DH,
            MLA_Q_LORA, MLA_KV_LORA, MLA_ROPE,
            RET_HEADS * RET_DK, RET_HEADS * RET_DK, RET_HEADS * RET_DV, RET_HEADS * RET_DV,
            N_BRANCH * D_MODEL)
IN_OFFSETS = tuple(sum(IN_SIZES[:j]) for j in range(1, len(IN_SIZES)))
N_IN = sum(IN_SIZES)

kernel_name = 'hybrid_gated_bidir_encoder'


def _rms_norm(x, g):
    x32 = x.astype(jnp.float32)
    y = x32 * lax.rsqrt(jnp.mean(x32 * x32, axis=-1, keepdims=True) + EPS)
    return (y * g.astype(jnp.float32)).astype(x.dtype)


def _head_layer_norm(x, g):
    x32 = x.astype(jnp.float32)
    xc = x32 - jnp.mean(x32, axis=-1, keepdims=True)
    var = jnp.mean(xc * xc, axis=-1, keepdims=True)
    return (xc * lax.rsqrt(var + EPS) * g.astype(jnp.float32)).astype(x.dtype)


def _rope_tables(seq, rot_dim, theta, dtype):
    pos = jnp.arange(seq, dtype=jnp.float32)
    inv_freq = theta ** (-jnp.arange(0, rot_dim, 2, dtype=jnp.float32) / rot_dim)
    ang = pos[:, None] * inv_freq[None, :]
    return jnp.cos(ang).astype(dtype), jnp.sin(ang).astype(dtype)


def _apply_rope(x, cos, sin):
    x1, x2 = jnp.split(x, 2, axis=-1)
    return jnp.concatenate([x1 * cos - x2 * sin, x2 * cos + x1 * sin], axis=-1)


def _partial_rope(x, cos, sin, rot):
    return jnp.concatenate([_apply_rope(x[..., :rot], cos, sin), x[..., rot:]], axis=-1)


def _blocked_queries(fn, qs):
    def to_blocks(t):
        b, h, s, d = t.shape
        return t.reshape(b, h, s // BLOCK_Q, BLOCK_Q, d).transpose(2, 0, 1, 3, 4)
    out = lax.map(fn, tuple(to_blocks(t) for t in qs))
    nb, b, h, qb, e = out.shape
    return out.transpose(1, 2, 0, 3, 4).reshape(b, h, nb * qb, e)


def _linear_recurrence_combine(left, right):
    a_l, b_l = left
    a_r, b_r = right
    return a_l * a_r, a_r * b_l + b_r


def _rglru_mixer(xa, ga, conv_w, conv_b, wa, ba, wx, bx, lam):
    b, s, w = xa.shape
    left = CONV_WIDTH // 2
    xp = jnp.pad(xa, ((0, 0), (left, CONV_WIDTH - 1 - left), (0, 0)))
    xc = conv_b
    for t in range(CONV_WIDTH):
        xc = xc + xp[:, t:t + s] * conv_w[t]
    xblk = xc.reshape(b, s, LRU_BLOCKS, LRU_BLOCK)
    h_sum = jnp.zeros_like(xc)
    for d in range(2):
        r = jax.nn.sigmoid(jnp.einsum('bsnc,ncd->bsnd', xblk, wa[d]).reshape(b, s, w) + ba[d])
        i = jax.nn.sigmoid(jnp.einsum('bsnc,ncd->bsnd', xblk, wx[d]).reshape(b, s, w) + bx[d])
        log_a = -LRU_C * r * jax.nn.softplus(-lam[d])
        a = jnp.exp(log_a)
        u = jnp.sqrt(-jnp.expm1(2.0 * log_a)) * (i * xc)
        _, h = lax.associative_scan(_linear_recurrence_combine, (a, u), axis=1, reverse=(d == 1))
        h_sum = h_sum + h
    return h_sum * jax.nn.gelu(ga)


def _diff_attention(q, k, v, q_g, k_g, lam_p, sub_g, lam_init, cos, sin):
    b, s, _ = q.shape
    q = _rms_norm(q.reshape(b, s, DIFF_HEADS, 2, DIFF_DH), q_g).transpose(0, 2, 3, 1, 4)
    k = _rms_norm(k.reshape(b, s, DIFF_HEADS, 2, DIFF_DH), k_g).transpose(0, 2, 3, 1, 4)
    v = v.reshape(b, s, DIFF_HEADS, 2 * DIFF_DH).transpose(0, 2, 1, 3)
    q = _partial_rope(q, cos, sin, DIFF_ROT)
    k = _partial_rope(k, cos, sin, DIFF_ROT)
    q1, q2 = q[:, :, 0], q[:, :, 1]
    k1, k2 = k[:, :, 0], k[:, :, 1]
    lp = lam_p.astype(jnp.float32)
    lam = jnp.exp(jnp.sum(lp[0] * lp[1])) - jnp.exp(jnp.sum(lp[2] * lp[3])) + lam_init
    scale = DIFF_DH ** -0.5

    def block(qb):
        q1b, q2b = qb
        a1 = jax.nn.softmax((jnp.einsum('bhqd,bhkd->bhqk', q1b, k1) * scale).astype(jnp.float32), axis=-1)
        a2 = jax.nn.softmax((jnp.einsum('bhqd,bhkd->bhqk', q2b, k2) * scale).astype(jnp.float32), axis=-1)
        return jnp.einsum('bhqk,bhke->bhqe', (a1 - lam * a2).astype(v.dtype), v)

    o = _blocked_queries(block, (q1, q2))
    o = _rms_norm(o, sub_g) * (1.0 - lam_init)
    return o.transpose(0, 2, 1, 3).reshape(b, s, DIFF_HEADS * 2 * DIFF_DH)


def _mla(cq, ckv, kpe, qa_g, wuq, kva_g, wukv, q_g, k_g, cos, sin):
    b, s, _ = cq.shape
    q = (_rms_norm(cq, qa_g) @ wuq).reshape(b, s, MLA_HEADS, MLA_NOPE + MLA_ROPE)
    kv = (_rms_norm(ckv, kva_g) @ wukv).reshape(b, s, MLA_HEADS, MLA_NOPE + MLA_V)
    k_nope, v = kv[..., :MLA_NOPE], kv[..., MLA_NOPE:]
    k = jnp.concatenate([k_nope, jnp.broadcast_to(kpe[:, :, None, :], (b, s, MLA_HEADS, MLA_ROPE))], axis=-1)
    q = _rms_norm(q, q_g).transpose(0, 2, 1, 3)
    k = _rms_norm(k, k_g).transpose(0, 2, 1, 3)
    v = v.transpose(0, 2, 1, 3)
    q = jnp.concatenate([q[..., :MLA_NOPE], _apply_rope(q[..., MLA_NOPE:], cos, sin)], axis=-1)
    k = jnp.concatenate([k[..., :MLA_NOPE], _apply_rope(k[..., MLA_NOPE:], cos, sin)], axis=-1)
    scale = (MLA_NOPE + MLA_ROPE) ** -0.5

    def block(qb):
        (q_b,) = qb
        a = jax.nn.softmax((jnp.einsum('bhqd,bhkd->bhqk', q_b, k) * scale).astype(jnp.float32), axis=-1)
        return jnp.einsum('bhqk,bhke->bhqe', a.astype(v.dtype), v)

    o = _blocked_queries(block, (q,))
    return o.transpose(0, 2, 1, 3).reshape(b, s, MLA_HEADS * MLA_V)


def _retention(q, k, v, g, gn_g, cos, sin):
    b, s, _ = q.shape
    nc = s // CHUNK
    q = _apply_rope(q.reshape(b, s, RET_HEADS, RET_DK).transpose(0, 2, 1, 3), cos, sin)
    k = _apply_rope(k.reshape(b, s, RET_HEADS, RET_DK).transpose(0, 2, 1, 3), cos, sin) * (RET_DK ** -0.5)
    v = v.reshape(b, s, RET_HEADS, RET_DV).transpose(0, 2, 1, 3)
    qc = q.reshape(b, RET_HEADS, nc, CHUNK, RET_DK)
    kc = k.reshape(b, RET_HEADS, nc, CHUNK, RET_DK)
    vc = v.reshape(b, RET_HEADS, nc, CHUNK, RET_DV)
    log_g = jnp.log1p(-jnp.exp2(-5.0 - jnp.arange(RET_HEADS, dtype=jnp.float32)))
    idx = jnp.arange(CHUNK, dtype=jnp.float32)
    dt = q.dtype
    d_intra = jnp.exp(log_g[:, None, None] * jnp.abs(idx[:, None] - idx[None, :])).astype(dt)
    d_tail = jnp.exp(log_g[:, None] * (CHUNK - 1.0 - idx)[None, :]).astype(dt)
    d_head = jnp.exp(log_g[:, None] * idx[None, :]).astype(dt)
    d_qf = jnp.exp(log_g[:, None] * (idx + 1.0)[None, :]).astype(dt)
    d_qb = jnp.exp(log_g[:, None] * (CHUNK - idx)[None, :]).astype(dt)
    intra = jnp.einsum('bhnij,bhnje->bhnie',
                       jnp.einsum('bhnid,bhnjd->bhnij', qc, kc) * d_intra[:, None], vc)
    kv_fwd = jnp.einsum('bhncd,bhnce->nbhde', kc * d_tail[:, None, :, None], vc)
    kv_bwd = jnp.einsum('bhncd,bhnce->nbhde', kc * d_head[:, None, :, None], vc)
    d_chunk = jnp.exp(log_g * CHUNK).astype(kv_fwd.dtype)[None, :, None, None]

    def step(carry, kv_c):
        return carry * d_chunk + kv_c, carry

    init = jnp.zeros((b, RET_HEADS, RET_DK, RET_DV), kv_fwd.dtype)
    _, past = lax.scan(step, init, kv_fwd)
    _, future = lax.scan(step, init, kv_bwd, reverse=True)
    cross = (jnp.einsum('bhnid,nbhde->bhnie', qc * d_qf[:, None, :, None], past)
             + jnp.einsum('bhnid,nbhde->bhnie', qc * d_qb[:, None, :, None], future))
    o = (intra + cross).reshape(b, RET_HEADS, s, RET_DV)
    o = _head_layer_norm(o, gn_g).transpose(0, 2, 1, 3).reshape(b, s, RET_HEADS * RET_DV)
    return jax.nn.silu(g) * o


def setup_inputs(seed: int = 0) -> dict:
    key = jax.random.key(seed)
    ks = jax.random.split(key, 34)
    L = DEPTH

    def nrm(k, shape, scale):
        return jax.random.normal(k, shape, jnp.float32) * scale

    def gain(k, shape):
        return 1.0 + 0.1 * jax.random.normal(k, shape, jnp.float32)

    a_c = jax.random.uniform(ks[11], (L, 2, LRU_WIDTH), jnp.float32, minval=0.9, maxval=0.999)
    a_base = a_c ** (1.0 / LRU_C)
    lru_lambda = jnp.log(a_base) - jnp.log1p(-a_base)
    return {
        'x': nrm(ks[0], (BATCH, SEQ, D_MODEL), 1.0),
        'p': nrm(ks[1], (DEPTH, BATCH, SEQ, PLE_DIM), 1.0),
        'norm1_g': gain(ks[2], (L, D_MODEL)),
        'w_in': nrm(ks[3], (L, D_MODEL, N_IN), D_MODEL ** -0.5),
        'gate_b': nrm(ks[4], (L, N_BRANCH, D_MODEL), 0.1),
        'conv_w': nrm(ks[5], (L, CONV_WIDTH, LRU_WIDTH), CONV_WIDTH ** -0.5),
        'conv_b': nrm(ks[6], (L, LRU_WIDTH), 0.01),
        'lru_wa': nrm(ks[7], (L, 2, LRU_BLOCKS, LRU_BLOCK, LRU_BLOCK), LRU_BLOCK ** -0.5),
        'lru_ba': nrm(ks[8], (L, 2, LRU_WIDTH), 0.1),
        'lru_wx': nrm(ks[9], (L, 2, LRU_BLOCKS, LRU_BLOCK, LRU_BLOCK), LRU_BLOCK ** -0.5),
        'lru_bx': nrm(ks[10], (L, 2, LRU_WIDTH), 0.1),
        'lru_lambda': lru_lambda,
        'diff_q_g': gain(ks[12], (L, DIFF_DH)),
        'diff_k_g': gain(ks[13], (L, DIFF_DH)),
        'diff_lam': nrm(ks[14], (L, 4, DIFF_DH), 0.1),
        'diff_sub_g': gain(ks[15], (L, 2 * DIFF_DH)),
        'mla_qa_g': gain(ks[16], (L, MLA_Q_LORA)),
        'mla_wuq': nrm(ks[17], (L, MLA_Q_LORA, MLA_HEADS * (MLA_NOPE + MLA_ROPE)), MLA_Q_LORA ** -0.5),
        'mla_kva_g': gain(ks[18], (L, MLA_KV_LORA)),
        'mla_wukv': nrm(ks[19], (L, MLA_KV_LORA, MLA_HEADS * (MLA_NOPE + MLA_V)), MLA_KV_LORA ** -0.5),
        'mla_q_g': gain(ks[20], (L, MLA_NOPE + MLA_ROPE)),
        'mla_k_g': gain(ks[21], (L, MLA_NOPE + MLA_ROPE)),
        'ret_gn_g': gain(ks[22], (L, RET_DV)),
        'w_br_a': nrm(ks[23], (L, LRU_WIDTH, D_MODEL), LRU_WIDTH ** -0.5),
        'w_br_b': nrm(ks[24], (L, DIFF_HEADS * 2 * DIFF_DH, D_MODEL), (DIFF_HEADS * 2 * DIFF_DH) ** -0.5),
        'w_br_c': nrm(ks[25], (L, MLA_HEADS * MLA_V, D_MODEL), (MLA_HEADS * MLA_V) ** -0.5),
        'w_br_d': nrm(ks[26], (L, RET_HEADS * RET_DV, D_MODEL), (RET_HEADS * RET_DV) ** -0.5),
        'w_out': nrm(ks[27], (L, D_MODEL, D_MODEL), D_MODEL ** -0.5),
        'norm2_g': gain(ks[28], (L, D_MODEL)),
        'w_ff1': nrm(ks[29], (L, D_MODEL, D_FF), D_MODEL ** -0.5),
        'w_ff2': nrm(ks[30], (L, D_FF, D_MODEL), D_FF ** -0.5),
        'norm3_g': gain(ks[31], (L, D_MODEL)),
        'w_ple_gate': nrm(ks[32], (L, D_MODEL, D_MODEL), D_MODEL ** -0.5),
        'w_ple_proj': nrm(ks[33], (L, PLE_DIM, D_MODEL), PLE_DIM ** -0.5),
    }


def reference(x, p, norm1_g, w_in, gate_b, conv_w, conv_b, lru_wa, lru_ba, lru_wx, lru_bx, lru_lambda,
              diff_q_g, diff_k_g, diff_lam, diff_sub_g, mla_qa_g, mla_wuq, mla_kva_g, mla_wukv,
              mla_q_g, mla_k_g, ret_gn_g, w_br_a, w_br_b, w_br_c, w_br_d, w_out, norm2_g,
              w_ff1, w_ff2, norm3_g, w_ple_gate, w_ple_proj):
    b, s, _ = x.shape
    cos_b, sin_b = _rope_tables(s, DIFF_ROT, ROPE_THETA, x.dtype)
    cos_c, sin_c = _rope_tables(s, MLA_ROPE, ROPE_THETA, x.dtype)
    cos_d, sin_d = _rope_tables(s, RET_DK, RET_THETA, x.dtype)
    for i in range(DEPTH):
        xn = _rms_norm(x, norm1_g[i])
        (a_x, a_g, b_q, b_k, b_v, c_q, c_kv, c_kpe,
         d_q, d_k, d_v, d_g, gate_logits) = jnp.split(xn @ w_in[i], IN_OFFSETS, axis=-1)
        y_a = _rglru_mixer(a_x, a_g, conv_w[i], conv_b[i], lru_wa[i], lru_ba[i], lru_wx[i], lru_bx[i],
                           lru_lambda[i])
        lam_init = 0.8 - 0.6 * math.exp(-0.3 * i)
        y_b = _diff_attention(b_q, b_k, b_v, diff_q_g[i], diff_k_g[i], diff_lam[i], diff_sub_g[i],
                              lam_init, cos_b, sin_b)
        y_c = _mla(c_q, c_kv, c_kpe, mla_qa_g[i], mla_wuq[i], mla_kva_g[i], mla_wukv[i],
                   mla_q_g[i], mla_k_g[i], cos_c, sin_c)
        y_d = _retention(d_q, d_k, d_v, d_g, ret_gn_g[i], cos_d, sin_d)
        gates = jax.nn.sigmoid(gate_logits.reshape(b, s, N_BRANCH, D_MODEL) + gate_b[i])
        merged = (gates[:, :, 0] * (y_a @ w_br_a[i]) + gates[:, :, 1] * (y_b @ w_br_b[i])
                  + gates[:, :, 2] * (y_c @ w_br_c[i]) + gates[:, :, 3] * (y_d @ w_br_d[i]))
        x = x + merged @ w_out[i]
        h = _rms_norm(x, norm2_g[i])
        x = x + jnp.square(jax.nn.relu(h @ w_ff1[i])) @ w_ff2[i]
        ple_gate = jax.nn.sigmoid(_rms_norm(x, norm3_g[i]) @ w_ple_gate[i])
        x = x + ple_gate * (p[i] @ w_ple_proj[i])
    return x
```

```cpp
#include <hip/hip_runtime.h>
#include <hip/hip_cooperative_groups.h>
#include <cstdio>
namespace cg = cooperative_groups;

typedef unsigned short u16;
typedef unsigned int u32;
typedef short bf16x8 __attribute__((ext_vector_type(8)));
typedef float f32x16 __attribute__((ext_vector_type(16)));
typedef __bf16 bf2_t __attribute__((ext_vector_type(2)));
typedef float f2_t __attribute__((ext_vector_type(2)));
typedef u32 u32x4 __attribute__((ext_vector_type(4)));
typedef u32 u32x2 __attribute__((ext_vector_type(2)));
typedef float f32x4 __attribute__((ext_vector_type(4)));

#define DI __device__ __forceinline__
#define MFMA32(a, b, c) __builtin_amdgcn_mfma_f32_32x32x16_bf16((a), (b), (c), 0, 0, 0)

constexpr int SEQ = 4096, NBATCH = 16, TT = NBATCH * SEQ, NLAYER = 2;
constexpr int LDY = 13056;
constexpr int O_AX = 0, O_AG = 1024, O_BQ = 2048, O_BK = 3072, O_BV = 4096, O_DV = 5120, O_DQ = 6144,
              O_DK = 6656, O_DG = 7168, O_GT = 8192, O_CQ = 12288, O_CKV = 12672, O_KPE = 12928, O_END = 12992;
constexpr float EPSV = 1e-6f;
constexpr float LOG2E = 1.4426950408889634f;
constexpr size_t W_IN = 0, W_UQ = 13369344, W_UKV = 13959168, W_BR = 14483456, W_OUT = 18677760,
                 W_FF1 = 19726336, W_FF2 = 23920640, W_PG = 28114944, W_PE = 29163520, W_LAYER = 29425664;
constexpr int CONV_TILES = 7184;
constexpr int NTHR = 512;
constexpr int SMEM_BYTES = 149504;
constexpr int RS_OFF = 147456;
#ifndef PHMASK
#define PHMASK 0xffff
#endif
#define PH(k) ((PHMASK >> (k)) & 1)
#ifndef DUPMASK
#define DUPMASK 0
#endif
#define DUP(k) (1 + ((DUPMASK >> (k)) & 1))

struct Params {
  const float* in[34];
  float* out;
  unsigned char* ws;
  int G;
  int pad;
};
enum { I_X = 0, I_P, I_N1G, I_WIN, I_GATEB, I_CONVW, I_CONVB, I_WA, I_BA, I_WX, I_BX, I_LAM, I_DQG, I_DKG, I_DLAM,
       I_DSUBG, I_QAG, I_WUQ, I_KVAG, I_WUKV, I_MQG, I_MKG, I_GNG, I_WBRA, I_WBRB, I_WBRC, I_WBRD, I_WOUT, I_N2G,
       I_WFF1, I_WFF2, I_N3G, I_WPG, I_WPE };

struct WsPtrs {
  unsigned* xbar; int* cnt; float* rope; u16* W; float* rinv; u16* Y; u16* XB; u16* MERGED; float* HF; u16* BVT; u16* DVT; u16* CVT;
  u16* QC; u16* KC; u16* YMIX; u16* H1; u16* XB2; float* SSA; float* SSB; float* SSC; u16* PB; u16* PF; float* KVS;
};
__host__ __device__ inline size_t ws_need(int G) {
  size_t TG = (size_t)G * SEQ;
  size_t b = 24576 + (size_t)NLAYER * W_LAYER * 2 + TG * 4 + 256;
  b += TG * LDY * 2;
  b += TG * 1024 * 2 * 2;
  b += TG * 1024 * 2 * 3;
  b += TG * 1536 * 2 * 2;
  b += TG * 4096 * 2;
  b += TG * 1024 * 2 + 3 * TG * 64;
  b += TG * 256 * 2;
  b += (size_t)G * 8 * 16 * 2 * 8192 * 2;
  return b + 4096;
}
DI WsPtrs ws_ptrs(unsigned char* ws, int G) {
  WsPtrs p; size_t TG = (size_t)G * SEQ; size_t o = 0;
  p.cnt = (int*)(ws + o); o += 4096;
  p.xbar = (unsigned*)(ws + o); o += 16384;
  p.rope = (float*)(ws + o); o += 4096;
  p.W = (u16*)(ws + o); o += (size_t)NLAYER * W_LAYER * 2;
  p.rinv = (float*)(ws + o); o += TG * 4 + 256;
  p.Y = (u16*)(ws + o); p.H1 = p.Y; o += TG * LDY * 2;
  p.XB = (u16*)(ws + o); p.HF = (float*)(ws + o); o += TG * 1024 * 2;
  p.MERGED = (u16*)(ws + o); o += TG * 1024 * 2;
  p.BVT = (u16*)(ws + o); o += TG * 1024 * 2;
  p.DVT = (u16*)(ws + o); o += TG * 1024 * 2;
  p.CVT = (u16*)(ws + o); o += TG * 1024 * 2;
  p.QC = (u16*)(ws + o); o += TG * 1536 * 2;
  p.KC = (u16*)(ws + o); o += TG * 1536 * 2;
  p.YMIX = (u16*)(ws + o); o += TG * 4096 * 2;
  p.XB2 = (u16*)(ws + o); o += TG * 1024 * 2;
  p.SSA = (float*)(ws + o); o += TG * 64;
  p.SSB = (float*)(ws + o); o += TG * 64;
  p.SSC = (float*)(ws + o); o += TG * 64;
  p.PB = (u16*)(ws + o); o += TG * 256 * 2;
  p.PF = (u16*)(ws + o); o += (size_t)G * 8 * 16 * 2 * 8192 * 2;
  p.KVS = p.HF;
  return p;
}

DI u32 pack2(float a, float b) { f2_t v = {a, b}; bf2_t r = __builtin_convertvector(v, bf2_t); return __builtin_bit_cast(u32, r); }
DI float bflo(u32 v) { return __uint_as_float(v << 16); }
DI float bfhi(u32 v) { return __uint_as_float(v & 0xffff0000u); }
DI int lane_id_l() { int l = __builtin_amdgcn_mbcnt_hi(-1, __builtin_amdgcn_mbcnt_lo(-1, 0)); asm volatile("" : "+v"(l)); return l; }
DI float shx(float v, int k) { return __int_as_float(__builtin_amdgcn_ds_bpermute((lane_id_l() ^ k) << 2, __float_as_int(v))); }
DI float wave_sum(float v) {
#pragma unroll
  for (int o = 32; o > 0; o >>= 1) v += shx(v, o);
  return v;
}
DI float sigmoidf_(float x) { return __builtin_amdgcn_rcpf(1.f + __builtin_amdgcn_exp2f(-LOG2E * x)); }
DI float gelu_tanh(float x) { float z = 0.7978845608028654f * (x + 0.044715f * x * x * x); float t = 1.f - 2.f * __builtin_amdgcn_rcpf(__builtin_amdgcn_exp2f(2.f * LOG2E * z) + 1.f); return 0.5f * x * (1.f + t); }
DI int get_tid() { int t = threadIdx.x; asm volatile("" : "+v"(t)); return t; }
DI int launder_s(int v) { asm volatile("" : "+s"(v)); return v; }
DI int crow(int e, int h) { return (e & 3) + 8 * (e >> 2) + 4 * h; }
DI void rot_cs(float pos, float frev, float& c, float& s) {
  float rev = pos * frev; rev -= floorf(rev);
  c = __builtin_amdgcn_cosf(rev); s = __builtin_amdgcn_sinf(rev);
}
DI int vperm(int s) { return (s & ~12) | ((s & 4) << 1) | ((s & 8) >> 1); }

DI void tile_map(int idx, int mtiles, int& mt, int& nt) {
  int xcd = idx & 7, j = idx >> 3, mper = mtiles >> 3;
  mt = xcd * mper + (j % mper); nt = j / mper;
}

template <bool SWAP, int NJ, bool AF32>
DI void gemm_main(const void* Ap, int lda, const u16* Bt, int ldb, int K, int m0, int n0, f32x16 (&acc)[2][NJ], unsigned char* smem) {
  constexpr int BN = 64 * NJ;
  constexpr int STG = (256 + BN) * 72;
  u16* S0 = (u16*)smem;
  const int tid = get_tid(), lane = tid & 63, w = tid >> 6, r = lane & 31, h = lane >> 5, wm = w >> 1, wn = w & 1;
  u32x4 ra[AF32 ? 8 : 4];
  u32x4 rb[NJ];
  const int crow_ = tid >> 3, ckc = tid & 7;
  const u32 aoffb = (u32)(crow_ * lda + 8 * ckc) * (AF32 ? 4u : 2u);
  const u32 boffb = (u32)(crow_ * ldb + 8 * ckc) * 2u;
  const char* Abase = (const char*)Ap + (size_t)m0 * lda * (AF32 ? 4 : 2);
  const char* Bbase = (const char*)Bt + (size_t)n0 * ldb * 2;
  auto gload = [&](int k0) __attribute__((always_inline)) {
    if constexpr (AF32) {
#pragma unroll
      for (int i = 0; i < 4; ++i) {
        const char* p = Abase + ((size_t)i * 64 * lda + k0) * 4 + aoffb;
        ra[2 * i] = *(const u32x4*)p; ra[2 * i + 1] = *(const u32x4*)(p + 16);
      }
    } else {
#pragma unroll
      for (int i = 0; i < 4; ++i) ra[i] = *(const u32x4*)(Abase + ((size_t)i * 64 * lda + k0) * 2 + aoffb);
    }
#pragma unroll
    for (int i = 0; i < NJ; ++i) rb[i] = *(const u32x4*)(Bbase + ((size_t)i * 64 * ldb + k0) * 2 + boffb);
  };
  auto lstore = [&](int b) __attribute__((always_inline)) {
    u16* As = S0 + b * STG;
    u16* Bs = As + 256 * 72;
    if constexpr (AF32) {
#pragma unroll
      for (int i = 0; i < 4; ++i) {
        u32x4 a = ra[2 * i], bb = ra[2 * i + 1], o;
        o.x = pack2(__uint_as_float(a.x), __uint_as_float(a.y)); o.y = pack2(__uint_as_float(a.z), __uint_as_float(a.w));
        o.z = pack2(__uint_as_float(bb.x), __uint_as_float(bb.y)); o.w = pack2(__uint_as_float(bb.z), __uint_as_float(bb.w));
        *(u32x4*)(As + (crow_ + 64 * i) * 72 + 8 * ckc) = o;
      }
    } else {
#pragma unroll
      for (int i = 0; i < 4; ++i) *(u32x4*)(As + (crow_ + 64 * i) * 72 + 8 * ckc) = ra[i];
    }
#pragma unroll
    for (int i = 0; i < NJ; ++i) *(u32x4*)(Bs + (crow_ + 64 * i) * 72 + 8 * ckc) = rb[i];
  };
  const int nk = K >> 6;
  gload(0);
  __syncthreads();
  lstore(0);
  if (nk > 1) gload(64);
  __syncthreads();
#pragma unroll 1
  for (int t = 0; t < nk; ++t) {
    const u16* As = S0 + (t & 1) * STG;
    const u16* Bs = As + 256 * 72;
#pragma unroll
    for (int ks = 0; ks < 4; ++ks) {
      bf16x8 af[2], bf[NJ];
#pragma unroll
      for (int im = 0; im < 2; ++im) af[im] = *(const bf16x8*)(As + (64 * wm + 32 * im + r) * 72 + 16 * ks + 8 * h);
#pragma unroll
      for (int jn = 0; jn < NJ; ++jn) bf[jn] = *(const bf16x8*)(Bs + (32 * NJ * wn + 32 * jn + r) * 72 + 16 * ks + 8 * h);
#pragma unroll
      for (int im = 0; im < 2; ++im)
#pragma unroll
        for (int jn = 0; jn < NJ; ++jn)
          acc[im][jn] = SWAP ? MFMA32(bf[jn], af[im], acc[im][jn]) : MFMA32(af[im], bf[jn], acc[im][jn]);
    }
    if (t + 1 < nk) lstore((t + 1) & 1);
    if (t + 2 < nk) gload((t + 2) * 64);
    __syncthreads();
  }
}
template <int NJ>
DI void acc_zero(f32x16 (&acc)[2][NJ]) {
#pragma unroll
  for (int im = 0; im < 2; ++im)
#pragma unroll
    for (int jn = 0; jn < NJ; ++jn)
#pragma unroll
      for (int e = 0; e < 16; ++e) acc[im][jn][e] = 0.f;
}

template <int NJ>
DI void store_sw_bf16(const f32x16 (&acc)[2][NJ], u16* dst, int ld, int mrow0  , int ncol0  , int h, int nlimit) {
#pragma unroll
  for (int im = 0; im < 2; ++im) {
    u16* rowp = dst + (size_t)(mrow0 + 32 * im) * ld;
#pragma unroll
    for (int jn = 0; jn < NJ; ++jn)
#pragma unroll
      for (int g = 0; g < 4; ++g) {
        int n = ncol0 + 32 * jn + 8 * g + 4 * h;
        if (n < nlimit) {
          u32x2 o; o.x = pack2(acc[im][jn][4 * g], acc[im][jn][4 * g + 1]); o.y = pack2(acc[im][jn][4 * g + 2], acc[im][jn][4 * g + 3]);
          *(u32x2*)(rowp + n) = o;
        }
      }
  }
}
DI void store_vT(const f32x16 (&acc)[2][4], u16* vT, const float* rs, int mbase  , int nrel0  , int r, int h) {
#pragma unroll
  for (int im = 0; im < 2; ++im)
#pragma unroll
    for (int g = 0; g < 4; ++g) {
      int m = mbase + 32 * im + 8 * g + 4 * h;
      f32x4 sc = *(const f32x4*)(rs + m);
      int bl = m >> 12, s = m & 4095, sp = vperm(s);
#pragma unroll
      for (int jn = 0; jn < 4; ++jn) {
        int nrel = nrel0 + 32 * jn + r; int hh = nrel >> 7, dv = nrel & 127;
        u32x2 o; o.x = pack2(acc[im][jn][4 * g] * sc.x, acc[im][jn][4 * g + 1] * sc.y);
        o.y = pack2(acc[im][jn][4 * g + 2] * sc.z, acc[im][jn][4 * g + 3] * sc.w);
        *(u32x2*)(vT + ((size_t)((bl * 8 + hh) * 128 + dv)) * 4096 + sp) = o;
      }
    }
}

DI int inmap(int n) {
  if (n < 5120) return n;
  if (n < 6144) return n - 5120 + 6848;
  if (n < 6656) return n - 6144 + 5824;
  if (n < 7168) return n - 6656 + 6336;
  if (n < 8192) return n - 7168 + 7872;
  if (n < 12288) return n - 8192 + 8896;
  if (n < 12672) return n - 12288 + 5120;
  if (n < 12928) return n - 12672 + 5504;
  if (n < 12992) return n - 12928 + 5760;
  return -1;
}
DI void conv_tile(const float* src, int ld, int srccol0, int k0, const float* gain, u16* dst, int ldd, int n0, float* sm) {
  const int tid = get_tid(), tx = tid & 15, ty = tid >> 4;
#pragma unroll
  for (int i = 0; i < 2; ++i) {
    int k = ty + 32 * i;
    f32x4 v = f32x4{0.f, 0.f, 0.f, 0.f};
    if (srccol0 >= 0) v = *(const f32x4*)(src + (size_t)(k0 + k) * ld + srccol0 + 4 * tx);
    float g = gain ? gain[k0 + k] : 1.f;
    float* d = sm + k * 65 + 4 * tx;
    d[0] = v.x * g; d[1] = v.y * g; d[2] = v.z * g; d[3] = v.w * g;
  }
  __syncthreads();
  {
    int n = tid >> 3, ks = (tid & 7) * 8;
    u32 o[4];
#pragma unroll
    for (int j = 0; j < 4; ++j) o[j] = pack2(sm[(ks + 2 * j) * 65 + n], sm[(ks + 2 * j + 1) * 65 + n]);
    u16* d = dst + (size_t)(n0 + n) * ldd + k0 + ks;
    *(u32x4*)d = u32x4{o[0], o[1], o[2], o[3]};
  }
}

DI void phase_convert(const Params& P, const WsPtrs& W, unsigned char* smem) {
  float* sm = (float*)smem;
  int pp = 0;
  for (int t = blockIdx.x; t < NLAYER * CONV_TILES; t += gridDim.x) {
    int layer = t / CONV_TILES, u = t % CONV_TILES;
    u16* wl = W.W + (size_t)layer * W_LAYER;
    const float* src; const float* gain = nullptr; u16* dst; int K, ld, ntiles, kind = 0;
    if (u < 3264) { src = P.in[I_WIN] + (size_t)layer * 1024 * 12992; gain = P.in[I_N1G] + layer * 1024; dst = wl + W_IN; K = 1024; ld = 12992; ntiles = 204; kind = 1; }
    else if (u < 3408) { u -= 3264; src = P.in[I_WUQ] + (size_t)layer * 384 * 1536; gain = P.in[I_QAG] + layer * 384; dst = wl + W_UQ; K = 384; ld = 1536; ntiles = 24; }
    else if (u < 3536) { u -= 3408; src = P.in[I_WUKV] + (size_t)layer * 256 * 2048; gain = P.in[I_KVAG] + layer * 256; dst = wl + W_UKV; K = 256; ld = 2048; ntiles = 32; kind = 2; }
    else if (u < 4560) { u -= 3536; int j = u >> 8; u &= 255; src = P.in[I_WBRA + j] + (size_t)layer * 1048576; dst = wl + W_BR + (size_t)j * 1048576; K = 1024; ld = 1024; ntiles = 16; }
    else if (u < 4816) { u -= 4560; src = P.in[I_WOUT] + (size_t)layer * 1048576; dst = wl + W_OUT; K = 1024; ld = 1024; ntiles = 16; }
    else if (u < 5840) { u -= 4816; src = P.in[I_WFF1] + (size_t)layer * 4194304; gain = P.in[I_N2G] + layer * 1024; dst = wl + W_FF1; K = 1024; ld = 4096; ntiles = 64; }
    else if (u < 6864) { u -= 5840; src = P.in[I_WFF2] + (size_t)layer * 4194304; dst = wl + W_FF2; K = 4096; ld = 1024; ntiles = 16; }
    else if (u < 7120) { u -= 6864; src = P.in[I_WPG] + (size_t)layer * 1048576; gain = P.in[I_N3G] + layer * 1024; dst = wl + W_PG; K = 1024; ld = 1024; ntiles = 16; }
    else { u -= 7120; src = P.in[I_WPE] + (size_t)layer * 262144; dst = wl + W_PE; K = 256; ld = 1024; ntiles = 16; }
    int kt = u / ntiles, nt = u % ntiles, n0 = nt * 64, sc = n0;
    if (kind == 1) sc = inmap(n0);
    else if (kind == 2) { int hh = (n0 & 1023) >> 7, c = n0 & 127; sc = hh * 256 + c + (n0 >= 1024 ? 128 : 0); }
    conv_tile(src, ld, sc, kt * 64, gain, dst, K, n0, sm + pp * 4224);
    pp ^= 1;
  }
  if (blockIdx.x == 0) {
    for (int i = get_tid(); i < 1024; i += NTHR) W.cnt[i] = 0;
    for (int i = get_tid(); i < 4096; i += NTHR) W.xbar[i] = 0u;
    if (get_tid() < 72) {
      int i = get_tid(); double theta, rot; int j;
      if (i < 8) { theta = 500000.0; rot = 16.0; j = i; }
      else if (i < 40) { theta = 500000.0; rot = 64.0; j = i - 8; }
      else { theta = 10000.0; rot = 64.0; j = i - 40; }
      double invf = exp2(-(2.0 * j / rot) * log2(theta));
      W.rope[i] = (float)(invf / 6.283185307179586476925);
    }
  }
}

DI void phase_rowprep(const float* x, u16* xb, float* rinv, int nrows) {
  const int lane = get_tid() & 63, w = get_tid() >> 6;
  for (int row = blockIdx.x * 8 + w; row < nrows; row += gridDim.x * 8) {
    const float* xr = x + (size_t)row * 1024;
    f32x4 v[4]; float ss = 0.f;
#pragma unroll
    for (int i = 0; i < 4; ++i) { v[i] = *(const f32x4*)(xr + 256 * i + 4 * lane); ss += v[i].x * v[i].x + v[i].y * v[i].y + v[i].z * v[i].z + v[i].w * v[i].w; }
    ss = wave_sum(ss);
    if (lane == 0) rinv[row * 16] = ss;
#pragma unroll
    for (int i = 0; i < 4; ++i) { u32x2 o; o.x = pack2(v[i].x, v[i].y); o.y = pack2(v[i].z, v[i].w); *(u32x2*)(xb + (size_t)row * 1024 + 256 * i + 4 * lane) = o; }
  }
}

DI void tile_rinv(const float* ssp, int np, int m0, float* rs) {
  const int tid = get_tid(), row = tid >> 1, half = tid & 1;
  __syncthreads();
  const float* p = ssp + (size_t)(m0 + row) * 16;
  float ss = 0.f;
  if (np == 1) { ss = half ? 0.f : p[0]; }
  else { const int hn = np >> 1; for (int i = 0; i < hn; ++i) ss += p[half * hn + i]; }
  ss += shx(ss, 1);
  if (half == 0) rs[row] = rsqrtf(ss * (1.f / 1024.f) + EPSV);
}
DI void inproj_qk_sub(const Params& P, const WsPtrs& W, int layer, int m0, int n0, unsigned char* smem) {
  const int tid = get_tid(), lane = tid & 63, w = tid >> 6, r = lane & 31, h = lane >> 5, wm = w >> 1, wn = w & 1;
  float* rs = (float*)(smem + RS_OFF);
  tile_rinv(W.SSA, layer == 0 ? 1 : 16, m0, rs);
  const u16* Bt = W.W + (size_t)layer * W_LAYER + W_IN;
  f32x16 acc[2][2];
  acc_zero<2>(acc);
  gemm_main<true, 2, false>(W.XB, 1024, Bt, 1024, 1024, m0, n0, acc, smem);
  const int nw0 = n0 + 64 * wn;
  const int mrow0 = m0 + 64 * wm + r;
#pragma unroll
  for (int im = 0; im < 2; ++im) {
    float rv = rs[64 * wm + r + 32 * im];
#pragma unroll
    for (int jn = 0; jn < 2; ++jn)
#pragma unroll
      for (int e = 0; e < 16; ++e) acc[im][jn][e] *= rv;
  }
  if (nw0 < O_BV) {
    const bool isq = nw0 < O_BK;
    const float* gp = (isq ? P.in[I_DQG] : P.in[I_DKG]) + layer * 64;
    const float qs = isq ? 0.125f * LOG2E : 1.f;
#pragma unroll
    for (int im = 0; im < 2; ++im) {
      float pos = (float)((mrow0 + 32 * im) & 4095);
      float ss = 0.f;
#pragma unroll
      for (int jj = 0; jj < 2; ++jj)
#pragma unroll
        for (int e = 0; e < 16; ++e) ss += acc[im][jj][e] * acc[im][jj][e];
      ss += shx(ss, 32);
      float sc = rsqrtf(ss * (1.f / 64.f) + EPSV) * qs;
#pragma unroll
      for (int jj = 0; jj < 2; ++jj)
#pragma unroll
        for (int g = 0; g < 4; ++g) {
          f32x4 g4 = *(const f32x4*)(gp + 32 * jj + 8 * g + 4 * h);
          acc[im][jj][4 * g] *= sc * g4.x; acc[im][jj][4 * g + 1] *= sc * g4.y; acc[im][jj][4 * g + 2] *= sc * g4.z; acc[im][jj][4 * g + 3] *= sc * g4.w;
        }
#pragma unroll
      for (int e = 0; e < 4; ++e) {
        float c, sn; rot_cs(pos, W.rope[e + 4 * h], c, sn);
        float x1 = acc[im][0][e], x2 = acc[im][0][e + 4];
        acc[im][0][e] = x1 * c - x2 * sn;
        acc[im][0][e + 4] = x2 * c + x1 * sn;
      }
    }
  } else {
    const float ksc = (nw0 < O_DK) ? 1.f : 0.125f;
#pragma unroll
    for (int e = 0; e < 16; ++e) {
      float fr = W.rope[40 + crow(e, h)];
#pragma unroll
      for (int im = 0; im < 2; ++im) {
        float pos = (float)((mrow0 + 32 * im) & 4095);
        float c, sn; rot_cs(pos, fr, c, sn);
        float x1 = acc[im][0][e], x2 = acc[im][1][e];
        acc[im][0][e] = (x1 * c - x2 * sn) * ksc;
        acc[im][1][e] = (x2 * c + x1 * sn) * ksc;
      }
    }
  }
  store_sw_bf16<2>(acc, W.Y, LDY, mrow0, nw0, h, 1 << 30);
}

DI void inproj_tile(const Params& P, const WsPtrs& W, int layer, int mt, int nt, unsigned char* smem) {
  const int m0 = mt * 256, n0 = nt * 256;
  if ((n0 >= O_BQ && n0 < O_BV) || (n0 >= O_DQ && n0 < O_DG)) {
    inproj_qk_sub(P, W, layer, m0, n0, smem);
    inproj_qk_sub(P, W, layer, m0, n0 + 128, smem);
    return;
  }
  const int tid = get_tid(), lane = tid & 63, w = tid >> 6, r = lane & 31, h = lane >> 5, wm = w >> 1, wn = w & 1;
  const u16* Bt = W.W + (size_t)layer * W_LAYER + W_IN;
  float* rs = (float*)(smem + RS_OFF);
  tile_rinv(W.SSA, layer == 0 ? 1 : 16, m0, rs);
  f32x16 acc[2][4];
  acc_zero<4>(acc);
  const bool vsec = (n0 >= O_BV && n0 < O_DQ);
  if (vsec) {
    gemm_main<false, 4, false>(W.XB, 1024, Bt, 1024, 1024, m0, n0, acc, smem);
    int nw0 = n0 + 128 * wn;
    u16* vT = (nw0 < O_DV) ? W.BVT : W.DVT;
    int nrel0 = (nw0 < O_DV) ? nw0 - O_BV : nw0 - O_DV;
    store_vT(acc, vT, rs - m0, m0 + 64 * wm, nrel0, r, h);
    return;
  }
  gemm_main<true, 4, false>(W.XB, 1024, Bt, 1024, 1024, m0, n0, acc, smem);
  const int nw0 = n0 + 128 * wn;
  const int mrow0 = m0 + 64 * wm + r;
#pragma unroll
  for (int im = 0; im < 2; ++im) {
    float rv = rs[64 * wm + r + 32 * im];
#pragma unroll
    for (int jn = 0; jn < 4; ++jn)
#pragma unroll
      for (int e = 0; e < 16; ++e) acc[im][jn][e] *= rv;
  }
  store_sw_bf16<4>(acc, W.Y, LDY, mrow0, nw0, h, O_END);
}

DI void mla_up_tile(const WsPtrs& W, int layer, int item, int mtiles, unsigned char* smem) {
  const int tid = get_tid(), lane = tid & 63, w = tid >> 6, r = lane & 31, h = lane >> 5, wm = w >> 1, wn = w & 1;
  const bool isq = item < mtiles * 6;
  int mt, nt;
  if (isq) { mt = item / 6; nt = item % 6; } else { int u = item - mtiles * 6; mt = u >> 3; nt = u & 7; }
  const int m0 = mt * 256, n0 = nt * 256;
  const int K = isq ? 384 : 256;
  const u16* A = W.Y + (isq ? O_CQ : O_CKV);
  const u16* Bt = W.W + (size_t)layer * W_LAYER + (isq ? W_UQ : W_UKV);
  float* rs = (float*)(smem + RS_OFF);
  __syncthreads();
  {
    int row = tid >> 1, half = tid & 1, kh = K >> 1;
    const u16* p = A + (size_t)(m0 + row) * LDY + half * kh;
    float ss = 0.f;
    for (int c = 0; c < kh; c += 8) {
      u32x4 v = *(const u32x4*)(p + c);
      float a;
      a = bflo(v.x); ss += a * a; a = bfhi(v.x); ss += a * a; a = bflo(v.y); ss += a * a; a = bfhi(v.y); ss += a * a;
      a = bflo(v.z); ss += a * a; a = bfhi(v.z); ss += a * a; a = bflo(v.w); ss += a * a; a = bfhi(v.w); ss += a * a;
    }
    ss += shx(ss, 1);
    if (half == 0) rs[row] = rsqrtf(ss / (float)K + EPSV);
  }
  f32x16 acc[2][4];
  acc_zero<4>(acc);
  const bool vsec = (!isq) && nt >= 4;
  if (vsec) {
    gemm_main<false, 4, false>(A, LDY, Bt, K, K, m0, n0, acc, smem);
    store_vT(acc, W.CVT, rs - m0, m0 + 64 * wm, (n0 - 1024) + 128 * wn, r, h);
    return;
  }
  gemm_main<true, 4, false>(A, LDY, Bt, K, K, m0, n0, acc, smem);
  const int mrow0 = m0 + 64 * wm + r;
#pragma unroll
  for (int im = 0; im < 2; ++im) {
    float rv = rs[64 * wm + r + 32 * im];
#pragma unroll
    for (int jn = 0; jn < 4; ++jn)
#pragma unroll
      for (int e = 0; e < 16; ++e) acc[im][jn][e] *= rv;
  }
  const int nw0 = n0 + 128 * wn;
  if (isq) {
    store_sw_bf16<4>(acc, W.QC, 1536, mrow0, nw0, h, 1 << 30);
  } else {
    int hh = nw0 >> 7;
    store_sw_bf16<4>(acc, W.KC + hh * 192, 1536, mrow0, 0, h, 1 << 30);
  }
}

DI void mla_prep(const Params& P, const WsPtrs& W, int layer, int TG) {
  const int nrows = TG * 8;
  for (int base = blockIdx.x * 256; base < nrows; base += gridDim.x * 256) {
    int row = base + (get_tid() >> 1), half = get_tid() & 1;
    bool isq = row >= TG * 8;
    int rr = isq ? row - TG * 8 : row;
    int tok = rr >> 3, hh = rr & 7;
    u16* dst = (isq ? W.QC : W.KC) + (size_t)tok * 1536 + hh * 192 + half * 96;
    const float* g = (isq ? P.in[I_MQG] : P.in[I_MKG]) + layer * 192 + half * 96;
    float v[96];
    const u16* s0 = dst;
    const u16* s1 = (half == 1 && !isq) ? (W.Y + (size_t)tok * LDY + O_KPE) : dst + 32;
#pragma unroll
    for (int c = 0; c < 4; ++c) {
      u32x4 u = *(const u32x4*)(s0 + 8 * c);
      v[8 * c] = bflo(u.x); v[8 * c + 1] = bfhi(u.x); v[8 * c + 2] = bflo(u.y); v[8 * c + 3] = bfhi(u.y);
      v[8 * c + 4] = bflo(u.z); v[8 * c + 5] = bfhi(u.z); v[8 * c + 6] = bflo(u.w); v[8 * c + 7] = bfhi(u.w);
    }
#pragma unroll
    for (int c = 0; c < 8; ++c) {
      u32x4 u = *(const u32x4*)(s1 + 8 * c);
      v[32 + 8 * c] = bflo(u.x); v[32 + 8 * c + 1] = bfhi(u.x); v[32 + 8 * c + 2] = bflo(u.y); v[32 + 8 * c + 3] = bfhi(u.y);
      v[32 + 8 * c + 4] = bflo(u.z); v[32 + 8 * c + 5] = bfhi(u.z); v[32 + 8 * c + 6] = bflo(u.w); v[32 + 8 * c + 7] = bfhi(u.w);
    }
    float ss = 0.f;
#pragma unroll
    for (int i = 0; i < 96; ++i) ss += v[i] * v[i];
    ss += shx(ss, 1);
    float sc = rsqrtf(ss * (1.f / 192.f) + EPSV);
#pragma unroll
    for (int i = 0; i < 96; i += 4) {
      f32x4 g4 = *(const f32x4*)(g + i);
      v[i] *= sc * g4.x; v[i + 1] *= sc * g4.y; v[i + 2] *= sc * g4.z; v[i + 3] *= sc * g4.w;
    }
    if (half == 1) {
      float pos = (float)(tok & 4095);
#pragma unroll
      for (int i = 0; i < 32; ++i) {
        float c, s; rot_cs(pos, W.rope[8 + i], c, s);
        float x1 = v[32 + i], x2 = v[64 + i];
        v[32 + i] = x1 * c - x2 * s; v[64 + i] = x2 * c + x1 * s;
      }
    }
    const float qs = isq ? 0.07216878364870322f * LOG2E : 1.f;
#pragma unroll
    for (int c = 0; c < 12; ++c) {
      u32x4 o;
      o.x = pack2(v[8 * c] * qs, v[8 * c + 1] * qs); o.y = pack2(v[8 * c + 2] * qs, v[8 * c + 3] * qs);
      o.z = pack2(v[8 * c + 4] * qs, v[8 * c + 5] * qs); o.w = pack2(v[8 * c + 6] * qs, v[8 * c + 7] * qs);
      *(u32x4*)(dst + 8 * c) = o;
    }
  }
}

DI void p_convert(const float* pin, u16* pb, int n8) {
  for (int i = blockIdx.x * NTHR + get_tid(); i < n8; i += gridDim.x * NTHR) {
    const f32x4 a = *(const f32x4*)(pin + (size_t)i * 8), b = *(const f32x4*)(pin + (size_t)i * 8 + 4);
    u32x4 o; o.x = pack2(a.x, a.y); o.y = pack2(a.z, a.w); o.z = pack2(b.x, b.y); o.w = pack2(b.z, b.w);
    *(u32x4*)(pb + (size_t)i * 8) = o;
  }
}
template <int DKL, int DQK, int MODE>
DI void attn_core(const u16* Qw, int ldq, const u16* Kg, int ldk, const u16* VTg, int kcol_off, int qpos0, float dl,
                  f32x16 (&o)[4], float& l_out, unsigned char* smem, int kt0 = 0, int nkt = 64, bool zero_o = true, const bf16x8* qpre = nullptr) {
  constexpr int KST = DKL + 8;
  constexpr int KCH = DKL / 8;
  constexpr int NKL = DKL / 64;
  constexpr int NQ = DQK / 16;
  constexpr int STG = 64 * KST + 128 * 72;
  u16* S0 = (u16*)smem;
  const int tid = get_tid(), lane = tid & 63, r = lane & 31, h = lane >> 5;
  bf16x8 qf[NQ];
#pragma unroll
  for (int ks = 0; ks < NQ; ++ks) qf[ks] = qpre ? qpre[ks] : *(const bf16x8*)(Qw + (size_t)r * ldq + 16 * ks + 8 * h);
  if (zero_o) {
#pragma unroll
    for (int dt = 0; dt < 4; ++dt)
#pragma unroll
      for (int e = 0; e < 16; ++e) o[dt][e] = 0.f;
  }
  float m_run = -1e30f, l_run = 0.f;
  u32x4 rk[NKL], rv[2];
  u32 koff[NKL]; int klds[NKL];
#pragma unroll
  for (int i = 0; i < NKL; ++i) { int c = tid + NTHR * i; int row = c / KCH, kc = c % KCH; koff[i] = (u32)(row * ldk + 8 * kc) * 2u; klds[i] = row * KST + 8 * kc; }
  const u32 voff = (u32)((tid >> 3) * 4096 + 8 * (tid & 7)) * 2u;
  const int vlds = 64 * KST + (tid >> 3) * 72 + 8 * (tid & 7);
  auto gload = [&](int k0) __attribute__((always_inline)) {
    const char* kb = (const char*)Kg + (size_t)k0 * ldk * 2;
#pragma unroll
    for (int i = 0; i < NKL; ++i) rk[i] = *(const u32x4*)(kb + koff[i]);
    const char* vb = (const char*)VTg + (size_t)k0 * 2;
#pragma unroll
    for (int i = 0; i < 2; ++i) rv[i] = *(const u32x4*)(vb + (size_t)i * 64 * 4096 * 2 + voff);
  };
  auto lstore = [&](int b) __attribute__((always_inline)) {
    u16* St = S0 + b * STG;
#pragma unroll
    for (int i = 0; i < NKL; ++i) *(u32x4*)(St + klds[i]) = rk[i];
#pragma unroll
    for (int i = 0; i < 2; ++i) *(u32x4*)(St + vlds + i * 64 * 72) = rv[i];
  };
  gload(kt0 * 64);
  __syncthreads();
  lstore(0);
  gload((kt0 + 1) * 64);
  __syncthreads();
  const float qpos = (float)(qpos0 + r);
#pragma unroll 1
  for (int kt = 0; kt < nkt; ++kt) {
    const u16* Ks = S0 + (kt & 1) * STG;
    const u16* Vs = Ks + 64 * KST;
    f32x16 st[2];
#pragma unroll
    for (int t2 = 0; t2 < 2; ++t2)
#pragma unroll
      for (int e = 0; e < 16; ++e) st[t2][e] = (MODE == 1) ? -dl : 0.f;
    {
      constexpr int BPT = NQ / 4;
      constexpr int NBAT = 2 * BPT;
      bf16x8 kf[2][4];
#pragma unroll
      for (int i = 0; i < 4; ++i) kf[0][i] = *(const bf16x8*)(Ks + r * KST + kcol_off + 16 * i + 8 * h);
#pragma unroll
      for (int g = 0; g < NBAT; ++g) {
        if (g + 1 < NBAT) {
          const int t2n = (g + 1) / BPT, bn = (g + 1) % BPT;
#pragma unroll
          for (int i = 0; i < 4; ++i) kf[(g + 1) & 1][i] = *(const bf16x8*)(Ks + (32 * t2n + r) * KST + kcol_off + 16 * (4 * bn + i) + 8 * h);
        }
        __builtin_amdgcn_sched_barrier(0);
        const int t2 = g / BPT, b = g % BPT;
#pragma unroll
        for (int i = 0; i < 4; ++i) st[t2] = MFMA32(kf[g & 1][i], qf[4 * b + i], st[t2]);
        __builtin_amdgcn_sched_barrier(0);
      }
    }
    bf16x8 vf[2][4];
#pragma unroll
    for (int dt = 0; dt < 4; ++dt) vf[0][dt] = *(const bf16x8*)(Vs + (32 * dt + r) * 72 + 8 * h);
    if (MODE == 2) {
      const float kb = (float)((kt0 + kt) * 64 + 4 * h);
#pragma unroll
      for (int t2 = 0; t2 < 2; ++t2)
#pragma unroll
        for (int e = 0; e < 16; ++e) {
          float kp = kb + (float)(32 * t2 + (e & 3) + 8 * (e >> 2));
          st[t2][e] *= __builtin_amdgcn_exp2f(dl * fabsf(qpos - kp));
        }
    } else if (MODE == 1) {
      float ls = 0.f;
#pragma unroll
      for (int t2 = 0; t2 < 2; ++t2)
#pragma unroll
        for (int e = 0; e < 16; ++e) { float p = __builtin_amdgcn_exp2f(st[t2][e]); st[t2][e] = p; ls += p; }
      l_run += ls;
    } else {
      float mx = st[0][0];
#pragma unroll
      for (int t2 = 0; t2 < 2; ++t2)
#pragma unroll
        for (int e = 0; e < 16; ++e) mx = fmaxf(mx, st[t2][e]);
      mx = fmaxf(mx, shx(mx, 32));
      float mnew = fmaxf(m_run, mx);
      float alpha = __builtin_amdgcn_exp2f(m_run - mnew);
      const bool changed = mnew > m_run;
      m_run = mnew;
      float ls = 0.f;
#pragma unroll
      for (int t2 = 0; t2 < 2; ++t2)
#pragma unroll
        for (int e = 0; e < 16; ++e) { float p = __builtin_amdgcn_exp2f(st[t2][e] - mnew); st[t2][e] = p; ls += p; }
      l_run = l_run * alpha + ls;
      if (__any(changed)) {
#pragma unroll
        for (int dt = 0; dt < 4; ++dt)
#pragma unroll
          for (int e = 0; e < 16; ++e) o[dt][e] *= alpha;
      }
    }
#pragma unroll
    for (int c = 0; c < 4; ++c) {
      const int t2 = c >> 1, s2 = c & 1;
      if (c + 1 < 4) {
#pragma unroll
        for (int dt = 0; dt < 4; ++dt) vf[(c + 1) & 1][dt] = *(const bf16x8*)(Vs + (32 * dt + r) * 72 + 16 * (c + 1) + 8 * h);
      }
      u32x4 pk;
      pk.x = pack2(st[t2][8 * s2], st[t2][8 * s2 + 1]); pk.y = pack2(st[t2][8 * s2 + 2], st[t2][8 * s2 + 3]);
      pk.z = pack2(st[t2][8 * s2 + 4], st[t2][8 * s2 + 5]); pk.w = pack2(st[t2][8 * s2 + 6], st[t2][8 * s2 + 7]);
      bf16x8 pf = __builtin_bit_cast(bf16x8, pk);
      __builtin_amdgcn_sched_barrier(0);
#pragma unroll
      for (int dt = 0; dt < 4; ++dt) o[dt] = MFMA32(vf[c & 1][dt], pf, o[dt]);
      __builtin_amdgcn_sched_barrier(0);
    }
    if (kt + 1 < nkt) lstore((kt + 1) & 1);
    if (kt + 2 < nkt) gload((kt0 + kt + 2) * 64);
    __syncthreads();
  }
  l_out = l_run + shx(l_run, 32);
}

DI void store_o(const f32x16 (&o)[4], u16* rowp, int h) {
#pragma unroll
  for (int dt = 0; dt < 4; ++dt)
#pragma unroll
    for (int g = 0; g < 4; ++g) {
      u32x2 v; v.x = pack2(o[dt][4 * g], o[dt][4 * g + 1]); v.y = pack2(o[dt][4 * g + 2], o[dt][4 * g + 3]);
      *(u32x2*)(rowp + 32 * dt + 8 * g + 4 * h) = v;
    }
}


DI void ret_kv_item(const WsPtrs& W, int item, unsigned char* smem) {
  const int tid = get_tid(), lane = tid & 63, w = tid >> 6, r = lane & 31, h = lane >> 5;
  const int bh = item >> 4, qb = item & 15, bl = bh >> 3, hh = bh & 7;
  const float dl = log2f(1.f - exp2f(-5.f - (float)hh));
  u16* KTf = (u16*)smem;
  u16* KTb = KTf + 64 * 264;
  u16* VT = KTb + 64 * 264;
  const size_t tok0 = (size_t)bl * 4096 + qb * 256;
  __syncthreads();
  {
    const int j = tid >> 1, half = tid & 1;
    const u16* kp = W.Y + (tok0 + j) * LDY + O_DK + hh * 64 + half * 32;
    const float wf = __builtin_amdgcn_exp2f(dl * (float)(255 - j)), wb = __builtin_amdgcn_exp2f(dl * (float)j);
    const int jp = vperm(j);
#pragma unroll
    for (int c = 0; c < 4; ++c) {
      const u32x4 u = *(const u32x4*)(kp + 8 * c);
      const float kv[8] = {bflo(u.x), bfhi(u.x), bflo(u.y), bfhi(u.y), bflo(u.z), bfhi(u.z), bflo(u.w), bfhi(u.w)};
#pragma unroll
      for (int i = 0; i < 8; ++i) {
        const int dk = half * 32 + 8 * c + i;
        KTf[dk * 264 + jp] = (u16)pack2(kv[i] * wf, 0.f);
        KTb[dk * 264 + jp] = (u16)pack2(kv[i] * wb, 0.f);
      }
    }
    const u16* vp = W.DVT + (size_t)bh * 128 * 4096 + qb * 256;
#pragma unroll
    for (int i = 0; i < 8; ++i) {
      const int c = tid + 512 * i, row = c >> 5, kc = c & 31;
      *(u32x4*)(VT + row * 264 + 8 * kc) = *(const u32x4*)(vp + (size_t)row * 4096 + 8 * kc);
    }
  }
  __syncthreads();
  const int tk = w >> 2, tv = w & 3;
  f32x16 af, ab;
#pragma unroll
  for (int e = 0; e < 16; ++e) { af[e] = 0.f; ab[e] = 0.f; }
#pragma unroll
  for (int ks = 0; ks < 16; ++ks) {
    const bf16x8 vfr = *(const bf16x8*)(VT + (32 * tv + r) * 264 + 16 * ks + 8 * h);
    const bf16x8 kff = *(const bf16x8*)(KTf + (32 * tk + r) * 264 + 16 * ks + 8 * h);
    const bf16x8 kfb = *(const bf16x8*)(KTb + (32 * tk + r) * 264 + 16 * ks + 8 * h);
    af = MFMA32(kff, vfr, af);
    ab = MFMA32(kfb, vfr, ab);
  }
  float* dst = W.KVS + ((size_t)((bh * 16 + qb) * 2)) * 8192 + (32 * tv + r) * 64 + 32 * tk + 4 * h;
#pragma unroll
  for (int g = 0; g < 4; ++g) {
    *(f32x4*)(dst + 8 * g) = f32x4{af[4 * g], af[4 * g + 1], af[4 * g + 2], af[4 * g + 3]};
    *(f32x4*)(dst + 8192 + 8 * g) = f32x4{ab[4 * g], ab[4 * g + 1], ab[4 * g + 2], ab[4 * g + 3]};
  }
}
DI void ret_state_scan(const WsPtrs& W, int G) {
  const int nthr = G * 8 * 2048;
  for (int i = blockIdx.x * NTHR + get_tid(); i < nthr; i += gridDim.x * NTHR) {
    const int bh = i >> 11, e4 = (i & 2047) * 4, hh = bh & 7;
    const float g256 = exp2f(256.f * log2f(1.f - exp2f(-5.f - (float)hh)));
    const float* kv = W.KVS + (size_t)bh * 16 * 2 * 8192 + e4;
    u16* pf = W.PF + (size_t)bh * 16 * 2 * 8192 + e4;
    f32x4 st = f32x4{0.f, 0.f, 0.f, 0.f};
#pragma unroll 4
    for (int qb = 0; qb < 16; ++qb) {
      u32x2 o2; o2.x = pack2(st.x, st.y); o2.y = pack2(st.z, st.w);
      *(u32x2*)(pf + (size_t)(qb * 2) * 8192) = o2;
      const f32x4 a = *(const f32x4*)(kv + (size_t)(qb * 2) * 8192);
      st.x = st.x * g256 + a.x; st.y = st.y * g256 + a.y; st.z = st.z * g256 + a.z; st.w = st.w * g256 + a.w;
    }
    st = f32x4{0.f, 0.f, 0.f, 0.f};
#pragma unroll 4
    for (int qb = 15; qb >= 0; --qb) {
      u32x2 o2; o2.x = pack2(st.x, st.y); o2.y = pack2(st.z, st.w);
      *(u32x2*)(pf + (size_t)(qb * 2 + 1) * 8192) = o2;
      const f32x4 a = *(const f32x4*)(kv + (size_t)(qb * 2 + 1) * 8192);
      st.x = st.x * g256 + a.x; st.y = st.y * g256 + a.y; st.z = st.z * g256 + a.z; st.w = st.w * g256 + a.w;
    }
  }
}

DI void mla_attn_item(const WsPtrs& W, const float* pgq, const float* pgk, int item, unsigned char* smem) {
  const int w = get_tid() >> 6, lane = get_tid() & 63, r = lane & 31, h = lane >> 5;
  int bh = item >> 4, qb = item & 15, bl = bh >> 3, hh = bh & 7;
  int q0 = qb * 256 + 32 * w;
  size_t tokb = (size_t)bl * 4096;
  f32x16 o[4]; float l;
  float gq = 0.f, gk = 0.f;
  for (int i = lane; i < 192; i += 64) { gq = fmaxf(gq, fabsf(pgq[i])); gk = fmaxf(gk, fabsf(pgk[i])); }
#pragma unroll
  for (int of = 32; of > 0; of >>= 1) { gq = fmaxf(gq, shx(gq, of)); gk = fmaxf(gk, shx(gk, of)); }
  const float M = 19.99f * gq * gk * 1.02f + 1.f;
  bf16x8 qn[12];
  {
    const u16* Qr = W.QC + (tokb + q0 + r) * 1536 + hh * 192 + 8 * h;
    u32x4 raw[12];
#pragma unroll
    for (int ks = 0; ks < 12; ++ks) raw[ks] = *(const u32x4*)(Qr + 16 * ks);
    float ss = 0.f;
#pragma unroll
    for (int ks = 0; ks < 12; ++ks) {
      float a;
      a = bflo(raw[ks].x); ss += a * a; a = bfhi(raw[ks].x); ss += a * a; a = bflo(raw[ks].y); ss += a * a; a = bfhi(raw[ks].y); ss += a * a;
      a = bflo(raw[ks].z); ss += a * a; a = bfhi(raw[ks].z); ss += a * a; a = bflo(raw[ks].w); ss += a * a; a = bfhi(raw[ks].w); ss += a * a;
    }
    ss += shx(ss, 32);
    const float sc = rsqrtf(ss * (1.f / 192.f) + EPSV) * (0.07216878364870322f * LOG2E);
    const float pos = (float)(q0 + r);
    auto scaled = [&](int ks, float (&v)[8]) __attribute__((always_inline)) {
      const f32x4 g0 = *(const f32x4*)(pgq + 16 * ks + 8 * h), g1 = *(const f32x4*)(pgq + 16 * ks + 8 * h + 4);
      v[0] = bflo(raw[ks].x) * sc * g0.x; v[1] = bfhi(raw[ks].x) * sc * g0.y; v[2] = bflo(raw[ks].y) * sc * g0.z; v[3] = bfhi(raw[ks].y) * sc * g0.w;
      v[4] = bflo(raw[ks].z) * sc * g1.x; v[5] = bfhi(raw[ks].z) * sc * g1.y; v[6] = bflo(raw[ks].w) * sc * g1.z; v[7] = bfhi(raw[ks].w) * sc * g1.w;
    };
    auto packed = [&](const float (&v)[8]) __attribute__((always_inline)) {
      u32x4 p; p.x = pack2(v[0], v[1]); p.y = pack2(v[2], v[3]); p.z = pack2(v[4], v[5]); p.w = pack2(v[6], v[7]);
      return __builtin_bit_cast(bf16x8, p);
    };
#pragma unroll
    for (int ks = 0; ks < 8; ++ks) { float v[8]; scaled(ks, v); qn[ks] = packed(v); }
#pragma unroll
    for (int ks = 8; ks < 10; ++ks) {
      float x1[8], x2[8]; scaled(ks, x1); scaled(ks + 2, x2);
#pragma unroll
      for (int i = 0; i < 8; ++i) {
        float c, sn; rot_cs(pos, W.rope[8 + 16 * (ks - 8) + 8 * h + i], c, sn);
        const float a = x1[i] * c - x2[i] * sn, b = x2[i] * c + x1[i] * sn;
        x1[i] = a; x2[i] = b;
      }
      qn[ks] = packed(x1); qn[ks + 2] = packed(x2);
    }
  }
  if (M <= 56.f)
    attn_core<192, 192, 1>(W.QC + (tokb + q0) * 1536 + hh * 192, 1536, W.KC + tokb * 1536 + hh * 192, 1536,
                           W.CVT + (size_t)bh * 128 * 4096, 0, q0, M, o, l, smem, 0, 64, true, qn);
  else
    attn_core<192, 192, 0>(W.QC + (tokb + q0) * 1536 + hh * 192, 1536, W.KC + tokb * 1536 + hh * 192, 1536,
                           W.CVT + (size_t)bh * 128 * 4096, 0, q0, 0.f, o, l, smem, 0, 64, true, qn);
  float inv = 1.f / l;
#pragma unroll
  for (int dt = 0; dt < 4; ++dt)
#pragma unroll
    for (int e = 0; e < 16; ++e) o[dt][e] *= inv;
  store_o(o, W.YMIX + (tokb + q0 + r) * 4096 + 2048 + hh * 128, h);
}

DI void ret_attn_item(const Params& P, const WsPtrs& W, int layer, int item, unsigned char* smem) {
  const int w = get_tid() >> 6, lane = get_tid() & 63;
  int r = lane & 31, h = lane >> 5;
  int bh = item >> 4, qb = item & 15, bl = bh >> 3, hh = bh & 7;
  int q0 = qb * 256 + 32 * w;
  size_t tokb = (size_t)bl * 4096;
  float dl = log2f(1.f - exp2f(-5.f - (float)hh));
  f32x16 o[4]; float l;
  {
    const u16* Qw = W.Y + (tokb + q0) * LDY + O_DQ + hh * 64;
    bf16x8 qf[4];
#pragma unroll
    for (int ks = 0; ks < 4; ++ks) qf[ks] = *(const bf16x8*)(Qw + (size_t)r * LDY + 16 * ks + 8 * h);
    const float nrel = (float)(q0 - qb * 256 + r);
#pragma unroll
    for (int dir = 0; dir < 2; ++dir) {
      const u16* st = W.PF + ((size_t)((bh * 16 + qb) * 2 + dir)) * 8192;
      const float sc = __builtin_amdgcn_exp2f(dl * (dir == 0 ? nrel + 1.f : 256.f - nrel));
#pragma unroll
      for (int dt = 0; dt < 4; ++dt) {
        f32x16 tq;
#pragma unroll
        for (int e = 0; e < 16; ++e) tq[e] = 0.f;
#pragma unroll
        for (int ks = 0; ks < 4; ++ks) {
          bf16x8 af = *(const bf16x8*)(st + (32 * dt + r) * 64 + 16 * ks + 8 * h);
          tq = MFMA32(af, qf[ks], tq);
        }
#pragma unroll
        for (int e = 0; e < 16; ++e) o[dt][e] = (dir == 0 ? 0.f : o[dt][e]) + sc * tq[e];
      }
    }
  }
  attn_core<64, 64, 2>(W.Y + (tokb + q0) * LDY + O_DQ + hh * 64, LDY, W.Y + tokb * LDY + O_DK + hh * 64, LDY,
                          W.DVT + (size_t)bh * 128 * 4096, 0, q0, dl, o, l, smem, 4 * qb, 4, false);
  {
    const int it2 = launder_s(item), t2 = get_tid();
    bh = it2 >> 4; qb = it2 & 15; bl = bh >> 3; hh = bh & 7; q0 = qb * 256 + 32 * (t2 >> 6); tokb = (size_t)bl * 4096;
    r = (t2 & 63) & 31; h = (t2 & 63) >> 5;
  }
  float sm = 0.f;
#pragma unroll
  for (int dt = 0; dt < 4; ++dt)
#pragma unroll
    for (int e = 0; e < 16; ++e) sm += o[dt][e];
  sm += shx(sm, 32);
  float mean = sm * (1.f / 128.f), vs = 0.f;
#pragma unroll
  for (int dt = 0; dt < 4; ++dt)
#pragma unroll
    for (int e = 0; e < 16; ++e) { float d = o[dt][e] - mean; o[dt][e] = d; vs += d * d; }
  vs += shx(vs, 32);
  float sc = rsqrtf(vs * (1.f / 128.f) + EPSV);
  const float* gn = P.in[I_GNG] + layer * 128;
  const u16* gg = W.Y + (tokb + q0 + r) * LDY + O_DG + hh * 128;
#pragma unroll
  for (int dt = 0; dt < 4; ++dt)
#pragma unroll
    for (int g = 0; g < 4; ++g) {
      int c = 32 * dt + 8 * g + 4 * h;
      f32x4 g4 = *(const f32x4*)(gn + c);
      u32x2 sg = *(const u32x2*)(gg + c);
      float s0 = bflo(sg.x), s1 = bfhi(sg.x), s2 = bflo(sg.y), s3 = bfhi(sg.y);
      o[dt][4 * g] *= sc * g4.x * s0 * sigmoidf_(s0); o[dt][4 * g + 1] *= sc * g4.y * s1 * sigmoidf_(s1);
      o[dt][4 * g + 2] *= sc * g4.z * s2 * sigmoidf_(s2); o[dt][4 * g + 3] *= sc * g4.w * s3 * sigmoidf_(s3);
    }
  store_o(o, W.YMIX + (tokb + q0 + r) * 4096 + 3072 + hh * 128, h);
}

DI void diff_attn_item(const Params& P, const WsPtrs& W, int layer, int item, unsigned char* smem) {
  const int w = get_tid() >> 6, lane = get_tid() & 63, r = lane & 31, h = lane >> 5;
  int bh = item >> 5, qb = item & 31, bl = bh >> 3, hh = bh & 7;
  int sub = w >> 2;
  int q0 = qb * 128 + 32 * (w & 3);
  size_t tokb = (size_t)bl * 4096;
  f32x16 o[4]; float l;
  float gq = fabsf(P.in[I_DQG][layer * 64 + lane]), gk = fabsf(P.in[I_DKG][layer * 64 + lane]);
#pragma unroll
  for (int of = 32; of > 0; of >>= 1) { gq = fmaxf(gq, shx(gq, of)); gk = fmaxf(gk, shx(gk, of)); }
  const float M = 11.5416f * gq * gk * 1.02f + 1.f;
  if (M <= 56.f)
    attn_core<128, 64, 1>(W.Y + (tokb + q0) * LDY + O_BQ + hh * 128 + sub * 64, LDY, W.Y + tokb * LDY + O_BK + hh * 128, LDY,
                          W.BVT + (size_t)bh * 128 * 4096, sub * 64, q0, M, o, l, smem);
  else
    attn_core<128, 64, 0>(W.Y + (tokb + q0) * LDY + O_BQ + hh * 128 + sub * 64, LDY, W.Y + tokb * LDY + O_BK + hh * 128, LDY,
                          W.BVT + (size_t)bh * 128 * 4096, sub * 64, q0, 0.f, o, l, smem);
  float inv = 1.f / l;
  float* ex = (float*)smem;
  __syncthreads();
  if (sub == 1) {
#pragma unroll
    for (int dt = 0; dt < 4; ++dt)
#pragma unroll
      for (int e = 0; e < 16; ++e) ex[((w & 3) * 64 + dt * 16 + e) * 64 + lane] = o[dt][e] * inv;
  }
  __syncthreads();
  if (sub == 0) {
    const float* lp = P.in[I_DLAM] + layer * 256;
    float s1 = 0.f, s2 = 0.f;
    for (int i = 0; i < 64; ++i) { s1 += lp[i] * lp[64 + i]; s2 += lp[128 + i] * lp[192 + i]; }
    const float lam_init = (launder_s(layer) == 0) ? 0.2f : (0.8f - 0.6f * 0.7408182206817179f);
    const float lam = __expf(s1) - __expf(s2) + lam_init;
    float ss = 0.f;
#pragma unroll
    for (int dt = 0; dt < 4; ++dt)
#pragma unroll
      for (int e = 0; e < 16; ++e) {
        float v = o[dt][e] * inv - lam * ex[((w & 3) * 64 + dt * 16 + e) * 64 + lane];
        o[dt][e] = v; ss += v * v;
      }
    ss += shx(ss, 32);
    float sc = rsqrtf(ss * (1.f / 128.f) + EPSV) * (1.f - lam_init);
    const float* sg = P.in[I_DSUBG] + layer * 128;
#pragma unroll
    for (int dt = 0; dt < 4; ++dt)
#pragma unroll
      for (int g = 0; g < 4; ++g) {
        f32x4 g4 = *(const f32x4*)(sg + 32 * dt + 8 * g + 4 * h);
        o[dt][4 * g] *= sc * g4.x; o[dt][4 * g + 1] *= sc * g4.y; o[dt][4 * g + 2] *= sc * g4.z; o[dt][4 * g + 3] *= sc * g4.w;
      }
    store_o(o, W.YMIX + (tokb + q0 + r) * 4096 + 1024 + hh * 128, h);
  }
}

DI void lru_item(const Params& P, const WsPtrs& W, int layer, int item, unsigned char* smem) {
  const int tid = get_tid(), lane = tid & 63, w = tid >> 6, r = lane & 31, h = lane >> 5;
  const int bl = item >> 4, nb = item & 15, c0 = nb * 64;
  u16* XCb = (u16*)smem;
  float* XU = (float*)(smem + 18432);
  float* AA = (float*)(smem + 18432 + 34816);
  u16* WaT = (u16*)(smem + 18432 + 2 * 34816);
  u16* WxT = WaT + 64 * 72;
  float* CW = (float*)(smem + 18432 + 2 * 34816 + 2 * 9216);
  float* SEG = CW + 320;
  const size_t tokb = (size_t)bl * 4096;
  const u16* ax = W.Y + tokb * LDY + O_AX + c0;
  const u16* gag = W.Y + tokb * LDY + O_AG + c0;
  const int tt = tid >> 2, cg4 = tid & 3, cb16 = 16 * cg4;
  const int tm = w >> 1, tn = w & 1;
  __syncthreads();
  if (tid < 64) {
#pragma unroll
    for (int j = 0; j < 4; ++j) CW[j * 64 + tid] = P.in[I_CONVW][layer * 4096 + j * 1024 + c0 + tid];
    CW[4 * 64 + tid] = P.in[I_CONVB][layer * 1024 + c0 + tid];
  }
  for (int d = 0; d < 2; ++d) {
    __syncthreads();
    {
      const float* wa = P.in[I_WA] + ((size_t)((layer * 2 + d) * 16 + nb)) * 4096;
      const float* wx = P.in[I_WX] + ((size_t)((layer * 2 + d) * 16 + nb)) * 4096;
      int ci = tid >> 2;
      if (tid < 256)
#pragma unroll
      for (int q = 0; q < 4; ++q) {
        f32x4 a4 = *(const f32x4*)(wa + ci * 64 + cb16 + 4 * q);
        f32x4 x4 = *(const f32x4*)(wx + ci * 64 + cb16 + 4 * q);
        int co = cb16 + 4 * q;
        WaT[(co + 0) * 72 + ci] = (u16)pack2(a4.x, 0.f); WaT[(co + 1) * 72 + ci] = (u16)pack2(a4.y, 0.f);
        WaT[(co + 2) * 72 + ci] = (u16)pack2(a4.z, 0.f); WaT[(co + 3) * 72 + ci] = (u16)pack2(a4.w, 0.f);
        WxT[(co + 0) * 72 + ci] = (u16)pack2(x4.x, 0.f); WxT[(co + 1) * 72 + ci] = (u16)pack2(x4.y, 0.f);
        WxT[(co + 2) * 72 + ci] = (u16)pack2(x4.z, 0.f); WxT[(co + 3) * 72 + ci] = (u16)pack2(x4.w, 0.f);
      }
    }
    const int cl = 32 * tn + r;
    const float ba = P.in[I_BA][(layer * 2 + d) * 1024 + c0 + cl];
    const float bx = P.in[I_BX][(layer * 2 + d) * 1024 + c0 + cl];
    const float lamv = P.in[I_LAM][(layer * 2 + d) * 1024 + c0 + cl];
    const float sp = 8.f * log1pf(expf(-lamv));
    float carry = 0.f;
    u32x4 pre[8];
    auto lru_issue = [&](int t0n) __attribute__((always_inline)) {
#pragma unroll
      for (int j = 0; j < 4; ++j) {
        int t = t0n + tt + j - 2;
        if (t >= 0 && t < 4096) {
          pre[2 * j] = *(const u32x4*)(ax + (size_t)t * LDY + cb16);
          pre[2 * j + 1] = *(const u32x4*)(ax + (size_t)t * LDY + cb16 + 8);
        } else { pre[2 * j] = u32x4{0u, 0u, 0u, 0u}; pre[2 * j + 1] = u32x4{0u, 0u, 0u, 0u}; }
      }
    };
    lru_issue((d ? 31 : 0) * 128);
    for (int ci = 0; ci < 32; ++ci) {
      const int t0 = (d ? 31 - ci : ci) * 128;
      {
        float xc[16];
#pragma unroll
        for (int q = 0; q < 4; ++q) { f32x4 b4 = *(const f32x4*)(CW + 256 + cb16 + 4 * q); xc[4 * q] = b4.x; xc[4 * q + 1] = b4.y; xc[4 * q + 2] = b4.z; xc[4 * q + 3] = b4.w; }
#pragma unroll
        for (int j = 0; j < 4; ++j) {
          {
            u32x4 u0 = pre[2 * j], u1 = pre[2 * j + 1];
            float xv[16] = {bflo(u0.x), bfhi(u0.x), bflo(u0.y), bfhi(u0.y), bflo(u0.z), bfhi(u0.z), bflo(u0.w), bfhi(u0.w),
                            bflo(u1.x), bfhi(u1.x), bflo(u1.y), bfhi(u1.y), bflo(u1.z), bfhi(u1.z), bflo(u1.w), bfhi(u1.w)};
#pragma unroll
            for (int q = 0; q < 4; ++q) {
              f32x4 w4 = *(const f32x4*)(CW + j * 64 + cb16 + 4 * q);
              xc[4 * q] += xv[4 * q] * w4.x; xc[4 * q + 1] += xv[4 * q + 1] * w4.y; xc[4 * q + 2] += xv[4 * q + 2] * w4.z; xc[4 * q + 3] += xv[4 * q + 3] * w4.w;
            }
          }
        }
#pragma unroll
        for (int q = 0; q < 4; ++q) *(f32x4*)(XU + tt * 68 + cb16 + 4 * q) = f32x4{xc[4 * q], xc[4 * q + 1], xc[4 * q + 2], xc[4 * q + 3]};
        u32x4 o0, o1;
        o0.x = pack2(xc[0], xc[1]); o0.y = pack2(xc[2], xc[3]); o0.z = pack2(xc[4], xc[5]); o0.w = pack2(xc[6], xc[7]);
        o1.x = pack2(xc[8], xc[9]); o1.y = pack2(xc[10], xc[11]); o1.z = pack2(xc[12], xc[13]); o1.w = pack2(xc[14], xc[15]);
        *(u32x4*)(XCb + tt * 72 + cb16) = o0; *(u32x4*)(XCb + tt * 72 + cb16 + 8) = o1;
      }
      if (ci + 1 < 32) lru_issue((d ? 30 - ci : ci + 1) * 128);
      u32x4 g0, g1; f32x4 hfp[4];
      if (d == 1) {
        g0 = *(const u32x4*)(gag + (size_t)(t0 + tt) * LDY + cb16);
        g1 = *(const u32x4*)(gag + (size_t)(t0 + tt) * LDY + cb16 + 8);
        const float* hfr = W.HF + (tokb + t0 + tt) * 1024 + c0 + cb16;
#pragma unroll
        for (int q = 0; q < 4; ++q) hfp[q] = *(const f32x4*)(hfr + 4 * q);
      }
      __syncthreads();
      {
        f32x16 ra, rx;
#pragma unroll
        for (int e = 0; e < 16; ++e) { ra[e] = 0.f; rx[e] = 0.f; }
#pragma unroll
        for (int ks = 0; ks < 4; ++ks) {
          bf16x8 xa = *(const bf16x8*)(XCb + (32 * tm + r) * 72 + 16 * ks + 8 * h);
          bf16x8 wa = *(const bf16x8*)(WaT + (32 * tn + r) * 72 + 16 * ks + 8 * h);
          bf16x8 wx = *(const bf16x8*)(WxT + (32 * tn + r) * 72 + 16 * ks + 8 * h);
          ra = MFMA32(xa, wa, ra);
          rx = MFMA32(xa, wx, rx);
        }
#pragma unroll
        for (int e = 0; e < 16; ++e) {
          int tk = 32 * tm + crow(e, h);
          float rg = __builtin_amdgcn_rcpf(1.f + __builtin_amdgcn_exp2f(-LOG2E * (ra[e] + ba)));
          float ig = __builtin_amdgcn_rcpf(1.f + __builtin_amdgcn_exp2f(-LOG2E * (rx[e] + bx)));
          float a = __builtin_amdgcn_exp2f(-LOG2E * rg * sp);
          float xcv = XU[tk * 68 + cl];
          float u = __builtin_amdgcn_sqrtf(fmaxf(1.f - a * a, 0.f)) * ig * xcv;
          AA[tk * 68 + cl] = a; XU[tk * 68 + cl] = u;
        }
      }
      __syncthreads();
      {
        float hc = 0.f, pc = 1.f;
#pragma unroll
        for (int i = 0; i < 16; ++i) {
          const int io = 16 * w + i, tk = d ? 127 - io : io;
          const float a = AA[tk * 68 + lane], u = XU[tk * 68 + lane];
          hc = a * hc + u; pc = a * pc;
          XU[tk * 68 + lane] = hc; AA[tk * 68 + lane] = pc;
        }
        SEG[w * 64 + lane] = hc; SEG[512 + w * 64 + lane] = pc;
      }
      __syncthreads();
      {
        float cin = carry, cmine = carry;
#pragma unroll
        for (int ww = 0; ww < 8; ++ww) {
          if (ww == w) cmine = cin;
          cin = SEG[512 + ww * 64 + lane] * cin + SEG[ww * 64 + lane];
        }
        carry = cin;
#pragma unroll
        for (int i = 0; i < 16; ++i) {
          const int io = 16 * w + i, tk = d ? 127 - io : io;
          XU[tk * 68 + lane] += AA[tk * 68 + lane] * cmine;
        }
      }
      __syncthreads();
      {
        const size_t trow = tokb + t0 + tt;
        float hv[16];
#pragma unroll
        for (int q = 0; q < 4; ++q) { f32x4 v = *(const f32x4*)(XU + tt * 68 + cb16 + 4 * q); hv[4 * q] = v.x; hv[4 * q + 1] = v.y; hv[4 * q + 2] = v.z; hv[4 * q + 3] = v.w; }
        float* hf = W.HF + trow * 1024 + c0 + cb16;
        if (d == 0) {
#pragma unroll
          for (int q = 0; q < 4; ++q) *(f32x4*)(hf + 4 * q) = f32x4{hv[4 * q], hv[4 * q + 1], hv[4 * q + 2], hv[4 * q + 3]};
        } else {
          float gv[16] = {bflo(g0.x), bfhi(g0.x), bflo(g0.y), bfhi(g0.y), bflo(g0.z), bfhi(g0.z), bflo(g0.w), bfhi(g0.w),
                          bflo(g1.x), bfhi(g1.x), bflo(g1.y), bfhi(g1.y), bflo(g1.z), bfhi(g1.z), bflo(g1.w), bfhi(g1.w)};
#pragma unroll
          for (int q = 0; q < 16; ++q) gv[q] = gelu_tanh(gv[q]);
#pragma unroll
          for (int q = 0; q < 4; ++q) {
            f32x4 f = hfp[q];
            hv[4 * q] = (hv[4 * q] + f.x) * gv[4 * q]; hv[4 * q + 1] = (hv[4 * q + 1] + f.y) * gv[4 * q + 1];
            hv[4 * q + 2] = (hv[4 * q + 2] + f.z) * gv[4 * q + 2]; hv[4 * q + 3] = (hv[4 * q + 3] + f.w) * gv[4 * q + 3];
          }
          u32x4 o0, o1;
          o0.x = pack2(hv[0], hv[1]); o0.y = pack2(hv[2], hv[3]); o0.z = pack2(hv[4], hv[5]); o0.w = pack2(hv[6], hv[7]);
          o1.x = pack2(hv[8], hv[9]); o1.y = pack2(hv[10], hv[11]); o1.z = pack2(hv[12], hv[13]); o1.w = pack2(hv[14], hv[15]);
          u16* yo = W.YMIX + trow * 4096 + c0 + cb16;
          *(u32x4*)yo = o0; *(u32x4*)(yo + 8) = o1;
        }
      }
      __syncthreads();
    }
  }
}


typedef float f32x4v __attribute__((ext_vector_type(4)));
constexpr int G8_BK = 64, G8_HALF = 128, G8_HT = G8_HALF * G8_BK;
DI int g8_lds_byte(int r, int c) {
  int st = (r >> 4) * 2 + (c >> 5), rr = r & 15, cc = c & 31, ob = rr * 64 + cc * 2;
  return st * 1024 + (ob ^ (((ob >> 9) & 1) << 5));
}
DI void g8_stage_rc(int b, int& R, int& C) {
  int st = b / 1024, sb = b % 1024, swz = sb ^ (((sb >> 9) & 1) << 5);
  R = (st >> 1) * 16 + swz / 64; C = (st & 1) * 32 + (swz % 64) / 2;
}
DI void gemm8(const u16* A, int lda, const u16* Bt, int ldb, int K, int brow, int bcol, f32x4v (&acc)[2][2][4][2], unsigned char* smem) {
  u16* shm = (u16*)smem;
#define G8_SA(b, hh) (shm + ((b) * 2 + (hh)) * G8_HT)
#define G8_SB(b, hh) (shm + (4 + (b) * 2 + (hh)) * G8_HT)
#define G8_STAGE(P, BASE, LD, br, kt) do { const char* _gb = (const char*)(BASE) + ((long)(br) * (LD) + (long)(kt) * G8_BK) * 2; \
    const bool _isA = ((const void*)(BASE) == (const void*)A); \
    __builtin_amdgcn_global_load_lds((const unsigned*)(_gb + (_isA ? offA0 : offB0)), \
        (__attribute__((address_space(3))) unsigned*)((char*)(P) + ldsb), 16, 0, 0); \
    __builtin_amdgcn_global_load_lds((const unsigned*)(_gb + (_isA ? offA1 : offB1)), \
        (__attribute__((address_space(3))) unsigned*)((char*)(P) + ldsb + 8192), 16, 0, 0); } while (0)
#define G8_LDA(dst, b, hh) for (int m = 0; m < 4; ++m) for (int k = 0; k < 2; ++k) \
    dst[m][k] = *reinterpret_cast<const bf16x8*>((char*)G8_SA(b, hh) + aLds + m * 2048 + k * 1024)
#define G8_LDB(dst, b, hh) for (int n = 0; n < 2; ++n) for (int k = 0; k < 2; ++k) \
    dst[n][k] = *reinterpret_cast<const bf16x8*>((char*)G8_SB(b, hh) + bLds + n * 2048 + k * 1024)
#define G8_MMA(ai, bj, At_, Bt_) do { __builtin_amdgcn_s_setprio(1); \
    for (int m = 0; m < 4; ++m) for (int n = 0; n < 2; ++n) for (int k = 0; k < 2; ++k) \
      acc[ai][bj][m][n] = __builtin_amdgcn_mfma_f32_16x16x32_bf16(At_[m][k], Bt_[n][k], acc[ai][bj][m][n], 0, 0, 0); \
    __builtin_amdgcn_s_setprio(0); } while (0)
#define G8_WAIT_V(n) asm volatile("s_waitcnt vmcnt(" #n ")" ::: "memory")
#define G8_WAIT_L(n) asm volatile("s_waitcnt lgkmcnt(" #n ")" ::: "memory")
#define G8_BAR __builtin_amdgcn_s_barrier()
#define G8_SCHED __builtin_amdgcn_sched_barrier(0)
  const int tidx = get_tid();
  const int wid = tidx >> 6, lane = tidx & 63, wr = wid >> 2, wc = wid & 3, fr = lane & 15, fq = lane >> 4;
#pragma unroll
  for (int a = 0; a < 2; ++a)
#pragma unroll
    for (int b = 0; b < 2; ++b)
#pragma unroll
      for (int m = 0; m < 4; ++m)
#pragma unroll
        for (int n = 0; n < 2; ++n) acc[a][b][m][n] = f32x4v{0.f, 0.f, 0.f, 0.f};
  bf16x8 At[4][2], B0[2][2], B1[2][2];
  const int nt = K / G8_BK;
  const int ldsb = tidx * 16;
  const int aLds = g8_lds_byte(wr * 64 + fr, fq * 8), bLds = g8_lds_byte(wc * 32 + fr, fq * 8);
  u32 offA0, offA1, offB0, offB1;
  { int r0, c0, r1, c1; g8_stage_rc(ldsb, r0, c0); g8_stage_rc(ldsb + 8192, r1, c1);
    offA0 = (u32)(r0 * lda + c0) * 2u; offA1 = (u32)(r1 * lda + c1) * 2u; offB0 = (u32)(r0 * ldb + c0) * 2u; offB1 = (u32)(r1 * ldb + c1) * 2u; }
  __syncthreads();
  G8_STAGE(G8_SB(0, 0), Bt, ldb, bcol, 0); G8_STAGE(G8_SA(0, 0), A, lda, brow, 0);
  G8_STAGE(G8_SB(0, 1), Bt, ldb, bcol + G8_HALF, 0); G8_STAGE(G8_SA(0, 1), A, lda, brow + G8_HALF, 0);
  if (wr == 1) G8_BAR;
  G8_WAIT_V(4); G8_BAR;
  G8_STAGE(G8_SB(1, 0), Bt, ldb, bcol, 1); G8_STAGE(G8_SA(1, 0), A, lda, brow, 1); G8_STAGE(G8_SB(1, 1), Bt, ldb, bcol + G8_HALF, 1);
  G8_WAIT_V(6); G8_BAR;
  for (int t = 0; t < nt - 2; t += 2) {
    G8_LDB(B0, 0, 0); G8_SCHED; G8_LDA(At, 0, 0); G8_STAGE(G8_SA(1, 1), A, lda, brow + G8_HALF, t + 1);
    G8_WAIT_L(8); G8_BAR; G8_WAIT_L(0); G8_MMA(0, 0, At, B0); G8_BAR; G8_SCHED;
    G8_LDB(B1, 0, 1); G8_STAGE(G8_SB(0, 0), Bt, ldb, bcol, t + 2);
    G8_BAR; G8_WAIT_L(0); G8_MMA(0, 1, At, B1); G8_BAR;
    G8_LDA(At, 0, 1); G8_STAGE(G8_SA(0, 0), A, lda, brow, t + 2);
    G8_BAR; G8_WAIT_L(0); G8_MMA(1, 0, At, B0); G8_BAR; G8_SCHED;
    G8_STAGE(G8_SB(0, 1), Bt, ldb, bcol + G8_HALF, t + 2);
    G8_WAIT_V(6); G8_BAR; G8_MMA(1, 1, At, B1); G8_BAR;
    G8_LDB(B0, 1, 0); G8_SCHED; G8_LDA(At, 1, 0); G8_STAGE(G8_SA(0, 1), A, lda, brow + G8_HALF, t + 2);
    G8_WAIT_L(8); G8_BAR; G8_WAIT_L(0); G8_MMA(0, 0, At, B0); G8_BAR; G8_SCHED;
    G8_LDB(B1, 1, 1); G8_STAGE(G8_SB(1, 0), Bt, ldb, bcol, t + 3);
    G8_BAR; G8_WAIT_L(0); G8_MMA(0, 1, At, B1); G8_BAR;
    G8_LDA(At, 1, 1); G8_STAGE(G8_SA(1, 0), A, lda, brow, t + 3);
    G8_BAR; G8_WAIT_L(0); G8_MMA(1, 0, At, B0); G8_BAR; G8_SCHED;
    G8_STAGE(G8_SB(1, 1), Bt, ldb, bcol + G8_HALF, t + 3);
    G8_WAIT_V(6); G8_BAR; G8_MMA(1, 1, At, B1); G8_BAR;
  }
  { G8_LDB(B0, 0, 0); G8_LDA(At, 0, 0); G8_STAGE(G8_SA(1, 1), A, lda, brow + G8_HALF, nt - 1);
    G8_BAR; G8_WAIT_L(0); G8_MMA(0, 0, At, B0); G8_BAR;
    G8_LDB(B1, 0, 1); G8_BAR; G8_WAIT_L(0); G8_MMA(0, 1, At, B1); G8_BAR;
    G8_LDA(At, 0, 1); G8_WAIT_V(4); G8_BAR; G8_WAIT_L(0); G8_MMA(1, 0, At, B0); G8_MMA(1, 1, At, B1); G8_BAR; }
  { G8_LDB(B0, 1, 0); G8_LDA(At, 1, 0); G8_WAIT_V(2); G8_BAR; G8_WAIT_L(0); G8_MMA(0, 0, At, B0); G8_BAR;
    G8_LDB(B1, 1, 1); G8_WAIT_V(0); G8_BAR; G8_WAIT_L(0); G8_MMA(0, 1, At, B1); G8_BAR;
    G8_LDA(At, 1, 1); G8_BAR; G8_WAIT_L(0); G8_MMA(1, 0, At, B0); G8_MMA(1, 1, At, B1); G8_BAR; }
  if (wr == 0) G8_BAR;
}


DI void resid_store8(const f32x4v (&acc)[2][2][4][2], const float* xin, float* xout, u16* xb, float* ssp, int m0, int n0) {
  const int tid2 = get_tid();
  const int wid = tid2 >> 6, lane = tid2 & 63, wr = wid >> 2, wc = wid & 3, fr = lane & 15, fq = lane >> 4;
#pragma unroll
  for (int bj = 0; bj < 2; ++bj)
#pragma unroll
    for (int n = 0; n < 2; ++n) {
      const int row = m0 + bj * 128 + wc * 32 + n * 16 + fr;
#pragma unroll
      for (int ai = 0; ai < 2; ++ai) {
        float ss = 0.f;
        const int cb = n0 + ai * 128 + wr * 64;
#pragma unroll
        for (int m = 0; m < 4; ++m) {
          const size_t off = (size_t)row * 1024 + cb + m * 16 + fq * 4;
          f32x4 v = *(const f32x4*)(xin + off);
          f32x4v a = acc[ai][bj][m][n];
          v.x += a.x; v.y += a.y; v.z += a.z; v.w += a.w;
          *(f32x4*)(xout + off) = v;
          ss += v.x * v.x + v.y * v.y + v.z * v.z + v.w * v.w;
          u32x2 o2; o2.x = pack2(v.x, v.y); o2.y = pack2(v.z, v.w);
          *(u32x2*)(xb + off) = o2;
        }
        ss += shx(ss, 16);
        ss += shx(ss, 32);
        if (fq == 0) ssp[(size_t)row * 16 + (cb >> 6)] = ss;
      }
    }
}
DI void wout_tile8(const WsPtrs& W, int layer, const float* xin, float* xout, int mt, int nt, unsigned char* smem) {
  const int m0 = mt * 256, n0 = nt * 256;
  f32x4v acc[2][2][4][2];
  gemm8(W.W + (size_t)layer * W_LAYER + W_OUT, 1024, W.MERGED, 1024, 1024, n0, m0, acc, smem);
  resid_store8(acc, xin, xout, W.XB2, W.SSB, m0, n0);
}
DI void ffn2_tile8(const WsPtrs& W, int layer, float* x, int mt, int nt, unsigned char* smem) {
  const int m0 = mt * 256, n0 = nt * 256;
  f32x4v acc[2][2][4][2];
  gemm8(W.W + (size_t)layer * W_LAYER + W_FF2, 4096, W.H1, 4096, 4096, n0, m0, acc, smem);
  resid_store8(acc, x, x, W.XB2, W.SSC, m0, n0);
}

DI void inproj_tile8(const Params& P, const WsPtrs& W, int layer, int mt, int nt, unsigned char* smem) {
  const int m0 = mt * 256, n0 = nt * 256;
  const u16* Wt = W.W + (size_t)layer * W_LAYER + W_IN;
  float* rs = (float*)(smem + RS_OFF);
  tile_rinv(W.SSA, layer == 0 ? 1 : 16, m0, rs);
  f32x4v acc[2][2][4][2];
  if (n0 >= O_BV && n0 < O_DQ) {
    gemm8(W.XB, 1024, Wt, 1024, 1024, m0, n0, acc, smem);
    const int tid2 = get_tid();
    const int wid = tid2 >> 6, lane = tid2 & 63, wr = wid >> 2, wc = wid & 3, fr = lane & 15, fq = lane >> 4;
    u16* vT = (n0 < O_DV) ? W.BVT : W.DVT;
    const int nrel0 = (n0 < O_DV) ? n0 - O_BV : n0 - O_DV;
#pragma unroll
    for (int ai = 0; ai < 2; ++ai)
#pragma unroll
      for (int m = 0; m < 4; ++m) {
        const int tl = ai * 128 + wr * 64 + m * 16 + fq * 4;
        const f32x4 sc = *(const f32x4*)(rs + tl);
        const int mg = m0 + tl, bl = mg >> 12, sp = vperm(mg & 4095);
#pragma unroll
        for (int bj = 0; bj < 2; ++bj)
#pragma unroll
          for (int n = 0; n < 2; ++n) {
            const int nrel = nrel0 + bj * 128 + wc * 32 + n * 16 + fr, hh = nrel >> 7, dv = nrel & 127;
            f32x4v a = acc[ai][bj][m][n];
            u32x2 o2; o2.x = pack2(a.x * sc.x, a.y * sc.y); o2.y = pack2(a.z * sc.z, a.w * sc.w);
            *(u32x2*)(vT + ((size_t)((bl * 8 + hh) * 128 + dv)) * 4096 + sp) = o2;
          }
      }
    return;
  }
  gemm8(Wt, 1024, W.XB, 1024, 1024, n0, m0, acc, smem);
  const int tid2 = get_tid();
  const int wid = tid2 >> 6, lane = tid2 & 63, wr = wid >> 2, wc = wid & 3, fr = lane & 15, fq = lane >> 4;
  const bool qsec = (n0 >= O_BQ && n0 < O_BV), rsec = (n0 >= O_DQ && n0 < O_DG);
#pragma unroll
  for (int bj = 0; bj < 2; ++bj)
#pragma unroll
    for (int n = 0; n < 2; ++n) {
      const int tl = bj * 128 + wc * 32 + n * 16 + fr;
      const float rv = rs[tl];
      const float pos = (float)((m0 + tl) & 4095);
      u16* rowp = W.Y + (size_t)(m0 + tl) * LDY;
#pragma unroll
      for (int ai = 0; ai < 2; ++ai) {
        const int cb = n0 + ai * 128 + wr * 64;
        f32x4v v[4];
#pragma unroll
        for (int m = 0; m < 4; ++m) { v[m] = acc[ai][bj][m][n]; v[m].x *= rv; v[m].y *= rv; v[m].z *= rv; v[m].w *= rv; }
        if (qsec) {
          const bool isq = cb < O_BK;
          const float* gp = (isq ? P.in[I_DQG] : P.in[I_DKG]) + layer * 64;
          float ss = 0.f;
#pragma unroll
          for (int m = 0; m < 4; ++m) ss += v[m].x * v[m].x + v[m].y * v[m].y + v[m].z * v[m].z + v[m].w * v[m].w;
          ss += shx(ss, 16);
          ss += shx(ss, 32);
          const float sc = rsqrtf(ss * (1.f / 64.f) + EPSV) * (isq ? 0.125f * LOG2E : 1.f);
#pragma unroll
          for (int m = 0; m < 4; ++m) {
            const f32x4 g4 = *(const f32x4*)(gp + m * 16 + fq * 4);
            v[m].x *= sc * g4.x; v[m].y *= sc * g4.y; v[m].z *= sc * g4.z; v[m].w *= sc * g4.w;
          }
          const f32x4 fr4 = *(const f32x4*)(W.rope + (fq & 1) * 4);
          float mine[4] = {v[0].x, v[0].y, v[0].z, v[0].w}, frq[4] = {fr4.x, fr4.y, fr4.z, fr4.w}, outv[4];
#pragma unroll
          for (int j = 0; j < 4; ++j) {
            float c, sn; rot_cs(pos, frq[j], c, sn);
            float oth = shx(mine[j], 32);
            outv[j] = (fq < 2) ? (mine[j] * c - oth * sn) : (mine[j] * c + oth * sn);
          }
          v[0].x = outv[0]; v[0].y = outv[1]; v[0].z = outv[2]; v[0].w = outv[3];
        } else if (rsec) {
          const float ksc = (cb < O_DK) ? 1.f : 0.125f;
#pragma unroll
          for (int m = 0; m < 2; ++m) {
            const f32x4 f4 = *(const f32x4*)(W.rope + 40 + m * 16 + fq * 4);
            float frq[4] = {f4.x, f4.y, f4.z, f4.w};
            float x1[4] = {v[m].x, v[m].y, v[m].z, v[m].w}, x2[4] = {v[m + 2].x, v[m + 2].y, v[m + 2].z, v[m + 2].w};
#pragma unroll
            for (int j = 0; j < 4; ++j) {
              float c, sn; rot_cs(pos, frq[j], c, sn);
              float a = (x1[j] * c - x2[j] * sn) * ksc, b = (x2[j] * c + x1[j] * sn) * ksc;
              x1[j] = a; x2[j] = b;
            }
            v[m].x = x1[0]; v[m].y = x1[1]; v[m].z = x1[2]; v[m].w = x1[3];
            v[m + 2].x = x2[0]; v[m + 2].y = x2[1]; v[m + 2].z = x2[2]; v[m + 2].w = x2[3];
          }
        }
#pragma unroll
        for (int m = 0; m < 4; ++m) {
          const int f = cb + m * 16 + fq * 4;
          if (f < O_END) {
            u32x2 o2; o2.x = pack2(v[m].x, v[m].y); o2.y = pack2(v[m].z, v[m].w);
            *(u32x2*)(rowp + f) = o2;
          }
        }
      }
    }
}

DI void branch_tile8(const Params& P, const WsPtrs& W, int layer, int mt, int nt, unsigned char* smem) {
  const int m0 = mt * 256, n0 = nt * 256;
#pragma unroll 1
  for (int jb = 0; jb < 4; ++jb) {
    f32x4v acc[2][2][4][2];
    gemm8(W.W + (size_t)layer * W_LAYER + W_BR + (size_t)jb * 1048576, 1024, W.YMIX + jb * 1024, 4096, 1024, n0, m0, acc, smem);
    const int tid2 = get_tid();
    const int wid = tid2 >> 6, lane = tid2 & 63, wr = wid >> 2, wc = wid & 3, fr = lane & 15, fq = lane >> 4;
    const float* gbp = P.in[I_GATEB] + layer * 4096 + jb * 1024;
#pragma unroll
    for (int bj = 0; bj < 2; ++bj)
#pragma unroll
      for (int n = 0; n < 2; ++n) {
        const int row = m0 + bj * 128 + wc * 32 + n * 16 + fr;
        const u16* gp = W.Y + (size_t)row * LDY + O_GT + jb * 1024;
        u16* mp = W.MERGED + (size_t)row * 1024;
#pragma unroll
        for (int ai = 0; ai < 2; ++ai)
#pragma unroll
          for (int m = 0; m < 4; ++m) {
            const int f = n0 + ai * 128 + wr * 64 + m * 16 + fq * 4;
            const u32x2 gv = *(const u32x2*)(gp + f);
            const f32x4 b4 = *(const f32x4*)(gbp + f);
            f32x4v a = acc[ai][bj][m][n];
            float v0 = sigmoidf_(bflo(gv.x) + b4.x) * a.x, v1 = sigmoidf_(bfhi(gv.x) + b4.y) * a.y;
            float v2 = sigmoidf_(bflo(gv.y) + b4.z) * a.z, v3 = sigmoidf_(bfhi(gv.y) + b4.w) * a.w;
            if (jb > 0) { const u32x2 pv = *(const u32x2*)(mp + f); v0 += bflo(pv.x); v1 += bfhi(pv.x); v2 += bflo(pv.y); v3 += bfhi(pv.y); }
            u32x2 o2; o2.x = pack2(v0, v1); o2.y = pack2(v2, v3);
            *(u32x2*)(mp + f) = o2;
          }
      }
  }
}

DI void mla_up_tile8(const WsPtrs& W, int layer, int item, int mtiles, unsigned char* smem) {
  const int tid = get_tid();
  const bool isq = item < mtiles * 6;
  int mt, nt;
  if (isq) { mt = item / 6; nt = item % 6; } else { int u = item - mtiles * 6; mt = u >> 3; nt = u & 7; }
  const int m0 = mt * 256, n0 = nt * 256;
  const int K = isq ? 384 : 256;
  const u16* A = W.Y + (isq ? O_CQ : O_CKV);
  const u16* Bt = W.W + (size_t)layer * W_LAYER + (isq ? W_UQ : W_UKV);
  float* rs = (float*)(smem + RS_OFF);
  __syncthreads();
  {
    int row = tid >> 1, half = tid & 1, kh = K >> 1;
    const u16* p = A + (size_t)(m0 + row) * LDY + half * kh;
    float ss = 0.f;
    for (int c = 0; c < kh; c += 8) {
      u32x4 v = *(const u32x4*)(p + c);
      float a;
      a = bflo(v.x); ss += a * a; a = bfhi(v.x); ss += a * a; a = bflo(v.y); ss += a * a; a = bfhi(v.y); ss += a * a;
      a = bflo(v.z); ss += a * a; a = bfhi(v.z); ss += a * a; a = bflo(v.w); ss += a * a; a = bfhi(v.w); ss += a * a;
    }
    ss += shx(ss, 1);
    if (half == 0) rs[row] = rsqrtf(ss / (float)K + EPSV);
  }
  f32x4v acc[2][2][4][2];
  if (!isq && nt >= 4) {
    gemm8(A, LDY, Bt, K, K, m0, n0, acc, smem);
    const int tid2 = get_tid();
    const int wid = tid2 >> 6, lane = tid2 & 63, wr = wid >> 2, wc = wid & 3, fr = lane & 15, fq = lane >> 4;
#pragma unroll
    for (int ai = 0; ai < 2; ++ai)
#pragma unroll
      for (int m = 0; m < 4; ++m) {
        const int tl = ai * 128 + wr * 64 + m * 16 + fq * 4;
        const f32x4 sc = *(const f32x4*)(rs + tl);
        const int mg = m0 + tl, bl = mg >> 12, sp = vperm(mg & 4095);
#pragma unroll
        for (int bj = 0; bj < 2; ++bj)
#pragma unroll
          for (int n = 0; n < 2; ++n) {
            const int nrel = (n0 - 1024) + bj * 128 + wc * 32 + n * 16 + fr, hh = nrel >> 7, dv = nrel & 127;
            f32x4v a = acc[ai][bj][m][n];
            u32x2 o2; o2.x = pack2(a.x * sc.x, a.y * sc.y); o2.y = pack2(a.z * sc.z, a.w * sc.w);
            *(u32x2*)(W.CVT + ((size_t)((bl * 8 + hh) * 128 + dv)) * 4096 + sp) = o2;
          }
      }
    return;
  }
  gemm8(Bt, K, A, LDY, K, n0, m0, acc, smem);
  const int tid2 = get_tid();
  const int wid = tid2 >> 6, lane = tid2 & 63, wr = wid >> 2, wc = wid & 3, fr = lane & 15, fq = lane >> 4;
#pragma unroll
  for (int bj = 0; bj < 2; ++bj)
#pragma unroll
    for (int n = 0; n < 2; ++n) {
      const int tl = bj * 128 + wc * 32 + n * 16 + fr;
      const float rv = rs[tl];
      u16* rowp = (isq ? W.QC : W.KC) + (size_t)(m0 + tl) * 1536;
#pragma unroll
      for (int ai = 0; ai < 2; ++ai)
#pragma unroll
        for (int m = 0; m < 4; ++m) {
          const int f = n0 + ai * 128 + wr * 64 + m * 16 + fq * 4;
          const int dstc = isq ? f : ((f >> 7) * 192 + (f & 127));
          f32x4v a = acc[ai][bj][m][n];
          u32x2 o2; o2.x = pack2(a.x * rv, a.y * rv); o2.y = pack2(a.z * rv, a.w * rv);
          *(u32x2*)(rowp + dstc) = o2;
        }
    }
}

DI void pp_tile8(const WsPtrs& W, int layer, int mt, int nt, unsigned char* smem) {
  const int m0 = mt * 256, n0 = nt * 256;
  f32x4v acc[2][2][4][2];
  gemm8(W.W + (size_t)layer * W_LAYER + W_PE, 256, W.PB, 256, 256, n0, m0, acc, smem);
  const int tid2 = get_tid();
  const int wid = tid2 >> 6, lane = tid2 & 63, wr = wid >> 2, wc = wid & 3, fr = lane & 15, fq = lane >> 4;
#pragma unroll
  for (int bj = 0; bj < 2; ++bj)
#pragma unroll
    for (int n = 0; n < 2; ++n) {
      u16* rowp = W.MERGED + (size_t)(m0 + bj * 128 + wc * 32 + n * 16 + fr) * 1024 + n0 + wr * 64 + fq * 4;
#pragma unroll
      for (int ai = 0; ai < 2; ++ai)
#pragma unroll
        for (int m = 0; m < 4; ++m) {
          f32x4v a = acc[ai][bj][m][n];
          u32x2 o2; o2.x = pack2(a.x, a.y); o2.y = pack2(a.z, a.w);
          *(u32x2*)(rowp + ai * 128 + m * 16) = o2;
        }
    }
}
DI void ple_tile8(const WsPtrs& W, int layer, float* x, int mt, int nt, unsigned char* smem) {
  const int m0 = mt * 256, n0 = nt * 256;
  float* rs = (float*)(smem + RS_OFF);
  tile_rinv(W.SSC, 16, m0, rs);
  f32x4v acc[2][2][4][2];
  gemm8(W.W + (size_t)layer * W_LAYER + W_PG, 1024, W.XB2, 1024, 1024, n0, m0, acc, smem);
  {
    const int tid2 = get_tid();
    const int wid = tid2 >> 6, lane = tid2 & 63, wr = wid >> 2, wc = wid & 3, fr = lane & 15, fq = lane >> 4;
#pragma unroll
    for (int bj = 0; bj < 2; ++bj)
#pragma unroll
      for (int n = 0; n < 2; ++n) {
        const int tl = bj * 128 + wc * 32 + n * 16 + fr;
        const float rv = rs[tl];
        const u16* pp = W.MERGED + (size_t)(m0 + tl) * 1024 + n0 + wr * 64 + fq * 4;
#pragma unroll
        for (int ai = 0; ai < 2; ++ai)
#pragma unroll
          for (int m = 0; m < 4; ++m) {
            const u32x2 pv = *(const u32x2*)(pp + ai * 128 + m * 16);
            f32x4v a = acc[ai][bj][m][n];
            a.x = sigmoidf_(a.x * rv) * bflo(pv.x); a.y = sigmoidf_(a.y * rv) * bfhi(pv.x);
            a.z = sigmoidf_(a.z * rv) * bflo(pv.y); a.w = sigmoidf_(a.w * rv) * bfhi(pv.y);
            acc[ai][bj][m][n] = a;
          }
      }
  }
  resid_store8(acc, x, x, W.XB, W.SSA, m0, n0);
}

DI void ffn1_tile8(const WsPtrs& W, int layer, int mt, int nt, unsigned char* smem) {
  const int m0 = mt * 256, n0 = nt * 256;
  float* rs = (float*)(smem + RS_OFF);
  tile_rinv(W.SSB, 16, m0, rs);
  f32x4v acc[2][2][4][2];
  gemm8(W.W + (size_t)layer * W_LAYER + W_FF1, 1024, W.XB2, 1024, 1024, n0, m0, acc, smem);
  const int tid2 = get_tid();
  const int wid = tid2 >> 6, lane = tid2 & 63, wr = wid >> 2, wc = wid & 3, fr = lane & 15, fq = lane >> 4;
#pragma unroll
  for (int bj = 0; bj < 2; ++bj)
#pragma unroll
    for (int n = 0; n < 2; ++n) {
      const int tl = bj * 128 + wc * 32 + n * 16 + fr;
      const float rv = rs[tl];
      u16* rowp = W.H1 + (size_t)(m0 + tl) * 4096 + n0 + wr * 64 + fq * 4;
#pragma unroll
      for (int ai = 0; ai < 2; ++ai)
#pragma unroll
        for (int m = 0; m < 4; ++m) {
          f32x4v v = acc[ai][bj][m][n];
          float a0 = fmaxf(v.x * rv, 0.f), a1 = fmaxf(v.y * rv, 0.f), a2 = fmaxf(v.z * rv, 0.f), a3 = fmaxf(v.w * rv, 0.f);
          u32x2 o2; o2.x = pack2(a0 * a0, a1 * a1); o2.y = pack2(a2 * a2, a3 * a3);
          *(u32x2*)(rowp + ai * 128 + m * 16) = o2;
        }
    }
}

DI void branch_tile(const Params& P, const WsPtrs& W, int layer, int mt, int nt, unsigned char* smem) {
  const int tid = get_tid(), lane = tid & 63, w = tid >> 6, r = lane & 31, h = lane >> 5, wm = w >> 1, wn = w & 1;
  const int m0 = mt * 256, n0 = nt * 128;
  const int mrow0 = m0 + 64 * wm + r, nw0 = n0 + 64 * wn;
  f32x16 tot[2][2];
  acc_zero<2>(tot);
#pragma unroll 1
  for (int j = 0; j < 4; ++j) {
    f32x16 acc[2][2];
    acc_zero<2>(acc);
    gemm_main<true, 2, false>(W.YMIX + j * 1024, 4096, W.W + (size_t)layer * W_LAYER + W_BR + (size_t)j * 1048576, 1024, 1024, m0, n0, acc, smem);
#pragma unroll
    for (int im = 0; im < 2; ++im) {
      const u16* gp = W.Y + (size_t)(mrow0 + 32 * im) * LDY + O_GT + j * 1024 + nw0;
      const float* gbp = P.in[I_GATEB] + layer * 4096 + j * 1024 + nw0;
#pragma unroll
      for (int jn = 0; jn < 2; ++jn)
#pragma unroll
        for (int g = 0; g < 4; ++g) {
          u32x2 gv = *(const u32x2*)(gp + 32 * jn + 8 * g + 4 * h);
          f32x4 b4 = *(const f32x4*)(gbp + 32 * jn + 8 * g + 4 * h);
          tot[im][jn][4 * g] += sigmoidf_(bflo(gv.x) + b4.x) * acc[im][jn][4 * g]; tot[im][jn][4 * g + 1] += sigmoidf_(bfhi(gv.x) + b4.y) * acc[im][jn][4 * g + 1];
          tot[im][jn][4 * g + 2] += sigmoidf_(bflo(gv.y) + b4.z) * acc[im][jn][4 * g + 2]; tot[im][jn][4 * g + 3] += sigmoidf_(bfhi(gv.y) + b4.w) * acc[im][jn][4 * g + 3];
        }
    }
  }
  store_sw_bf16<2>(tot, W.MERGED, 1024, mrow0, nw0, h, 1 << 30);
}

template <int NJ>
DI void resid_store(const f32x16 (&acc)[2][NJ], const float* xin, float* xout, int mrow0, int nw0, int h) {
#pragma unroll
  for (int im = 0; im < 2; ++im)
#pragma unroll
    for (int jn = 0; jn < NJ; ++jn)
#pragma unroll
      for (int g = 0; g < 4; ++g) {
        size_t off = (size_t)(mrow0 + 32 * im) * 1024 + nw0 + 32 * jn + 8 * g + 4 * h;
        f32x4 v = *(const f32x4*)(xin + off);
        v.x += acc[im][jn][4 * g]; v.y += acc[im][jn][4 * g + 1]; v.z += acc[im][jn][4 * g + 2]; v.w += acc[im][jn][4 * g + 3];
        *(f32x4*)(xout + off) = v;
      }
}

template <int NJ>
DI void resid_store_x(const f32x16 (&acc)[2][NJ], const float* xin, float* xout, u16* xb, float* ssp, int slot, int mrow0, int nw0, int h) {
#pragma unroll
  for (int im = 0; im < 2; ++im) {
    float ss = 0.f;
#pragma unroll
    for (int jn = 0; jn < NJ; ++jn)
#pragma unroll
      for (int g = 0; g < 4; ++g) {
        size_t off = (size_t)(mrow0 + 32 * im) * 1024 + nw0 + 32 * jn + 8 * g + 4 * h;
        f32x4 v = *(const f32x4*)(xin + off);
        v.x += acc[im][jn][4 * g]; v.y += acc[im][jn][4 * g + 1]; v.z += acc[im][jn][4 * g + 2]; v.w += acc[im][jn][4 * g + 3];
        *(f32x4*)(xout + off) = v;
        ss += v.x * v.x + v.y * v.y + v.z * v.z + v.w * v.w;
        u32x2 o; o.x = pack2(v.x, v.y); o.y = pack2(v.z, v.w);
        *(u32x2*)(xb + off) = o;
      }
    ss += shx(ss, 32);
    if (h == 0) ssp[(size_t)(mrow0 + 32 * im) * 16 + slot] = ss;
  }
}

DI void wout_tile(const WsPtrs& W, int layer, const float* xin, float* xout, int mt, int nt, unsigned char* smem) {
  const int lane = get_tid() & 63, w = get_tid() >> 6, r = lane & 31, h = lane >> 5, wm = w >> 1, wn = w & 1;
  const int m0 = mt * 256, n0 = nt * 256;
  f32x16 acc[2][4];
  acc_zero<4>(acc);
  gemm_main<true, 4, false>(W.MERGED, 1024, W.W + (size_t)layer * W_LAYER + W_OUT, 1024, 1024, m0, n0, acc, smem);
  resid_store_x<4>(acc, xin, xout, W.XB2, W.SSB, (n0 + 128 * wn) >> 7, m0 + 64 * wm + r, n0 + 128 * wn, h);
}
DI void ffn1_tile(const WsPtrs& W, int layer, int mt, int nt, unsigned char* smem) {
  const int lane = get_tid() & 63, w = get_tid() >> 6, r = lane & 31, h = lane >> 5, wm = w >> 1, wn = w & 1;
  const int m0 = mt * 256, n0 = nt * 256;
  f32x16 acc[2][4];
  acc_zero<4>(acc);
  float* rs = (float*)(smem + RS_OFF);
  tile_rinv(W.SSB, 8, m0, rs);
  gemm_main<true, 4, false>(W.XB2, 1024, W.W + (size_t)layer * W_LAYER + W_FF1, 1024, 1024, m0, n0, acc, smem);
  const int mrow0 = m0 + 64 * wm + r;
#pragma unroll
  for (int im = 0; im < 2; ++im) {
    float rv = rs[64 * wm + r + 32 * im];
#pragma unroll
    for (int jn = 0; jn < 4; ++jn)
#pragma unroll
      for (int e = 0; e < 16; ++e) { float v = fmaxf(acc[im][jn][e] * rv, 0.f); acc[im][jn][e] = v * v; }
  }
  store_sw_bf16<4>(acc, W.H1, 4096, mrow0, n0 + 128 * wn, h, 1 << 30);
}
DI void ffn2_tile(const WsPtrs& W, int layer, float* x, int mt, int nt, unsigned char* smem) {
  const int lane = get_tid() & 63, w = get_tid() >> 6, r = lane & 31, h = lane >> 5, wm = w >> 1, wn = w & 1;
  const int m0 = mt * 256, n0 = nt * 256;
  f32x16 acc[2][4];
  acc_zero<4>(acc);
  gemm_main<true, 4, false>(W.H1, 4096, W.W + (size_t)layer * W_LAYER + W_FF2, 4096, 4096, m0, n0, acc, smem);
  resid_store_x<4>(acc, x, x, W.XB2, W.SSC, (n0 + 128 * wn) >> 7, m0 + 64 * wm + r, n0 + 128 * wn, h);
}
DI void ple_tile(const WsPtrs& W, int layer, float* x, const float* pin, int mt, int nt, unsigned char* smem) {
  const int lane = get_tid() & 63, w = get_tid() >> 6, r = lane & 31, h = lane >> 5, wm = w >> 1, wn = w & 1;
  const int m0 = mt * 256, n0 = nt * 128;
  const int mrow0 = m0 + 64 * wm + r;
  f32x16 gt[2][2];
  acc_zero<2>(gt);
  float* rs = (float*)(smem + RS_OFF);
  tile_rinv(W.SSC, 16, m0, rs);
  gemm_main<true, 2, false>(W.XB2, 1024, W.W + (size_t)layer * W_LAYER + W_PG, 1024, 1024, m0, n0, gt, smem);
#pragma unroll
  for (int im = 0; im < 2; ++im) {
    float rv = rs[64 * wm + r + 32 * im];
#pragma unroll
    for (int jn = 0; jn < 2; ++jn)
#pragma unroll
      for (int e = 0; e < 16; ++e) gt[im][jn][e] = sigmoidf_(gt[im][jn][e] * rv);
  }
  f32x16 acc[2][2];
  acc_zero<2>(acc);
  gemm_main<true, 2, true>(pin, 256, W.W + (size_t)layer * W_LAYER + W_PE, 256, 256, m0, n0, acc, smem);
#pragma unroll
  for (int im = 0; im < 2; ++im)
#pragma unroll
    for (int jn = 0; jn < 2; ++jn)
#pragma unroll
      for (int e = 0; e < 16; ++e) acc[im][jn][e] *= gt[im][jn][e];
  resid_store_x<2>(acc, x, x, W.XB, W.SSA, (n0 + 64 * wn) >> 6, mrow0, n0 + 64 * wn, h);
}

DI void gsync(unsigned* bar, unsigned* s_target) {
  asm volatile("s_waitcnt vmcnt(0)" ::: "memory");
  __syncthreads();
  if (threadIdx.x == 0) {
    const unsigned target = *s_target + gridDim.x;
    *s_target = target;
    __builtin_amdgcn_fence(__ATOMIC_RELEASE, "agent");
    asm volatile("s_waitcnt vmcnt(0)" ::: "memory");
    __hip_atomic_fetch_add(bar, 1u, __ATOMIC_RELAXED, __HIP_MEMORY_SCOPE_AGENT);
    while (__hip_atomic_load(bar, __ATOMIC_RELAXED, __HIP_MEMORY_SCOPE_AGENT) < target) __builtin_amdgcn_s_sleep(1);
    __builtin_amdgcn_fence(__ATOMIC_ACQUIRE, "agent");
    asm volatile("s_waitcnt vmcnt(0)" ::: "memory");
  }
  __syncthreads();
}

#define XB_TMO      128
#define XB_XCNT(j)  (256  + 64 * (j))
#define XB_XSUB(j)  (1280 + 64 * (j))
#define XB_XGEN(j)  (2304 + 64 * (j))
#define XB_TOP      3328
#define XB_TOPGEN   3392
#define XB_SPIN_CAP (1u << 20)
#define LAS __attribute__((address_space(3)))
DI unsigned xb_ld(unsigned* p) { return __hip_atomic_load(p, __ATOMIC_RELAXED, __HIP_MEMORY_SCOPE_AGENT); }
DI unsigned xb_add(unsigned* p, unsigned v) { return __hip_atomic_fetch_add(p, v, __ATOMIC_RELAXED, __HIP_MEMORY_SCOPE_AGENT); }
DI unsigned xb_xcc_id() { return (unsigned)__builtin_amdgcn_s_getreg((3 << 11) | 20) & 0xFu; }
#define XB_SPIN(cond, bar) do { unsigned _sp = 0; while (cond) { __builtin_amdgcn_s_sleep(1); \
    if ((++_sp & 255u) == 0u) { if (xb_ld(&(bar)[XB_TMO])) break; if (_sp > XB_SPIN_CAP) { atomicAdd(&(bar)[XB_TMO], 1u); break; } } } } while (0)
DI void xcd_barrier_post(unsigned* bar) { if (threadIdx.x == 0) (void)xb_add(&bar[XB_XCNT(xb_xcc_id())], 1u); }
DI void xcd_barrier_complete(unsigned* bar, unsigned x, unsigned& nloc, unsigned& nx) {
  const unsigned G = gridDim.x * gridDim.y * gridDim.z;
  unsigned sum, cnt, mine, sp = 0u;
  for (;;) {
    sum = 0u; cnt = 0u; mine = 0u;
#pragma unroll
    for (unsigned j = 0; j < 16; ++j) { const unsigned c = xb_ld(&bar[XB_XCNT(j)]); sum += c; cnt += (c > 0u) ? 1u : 0u; mine = (j == x) ? c : mine; }
    if (sum == G) break;
    __builtin_amdgcn_s_sleep(1);
    if ((++sp & 255u) == 0u) { if (xb_ld(&bar[XB_TMO])) break; if (sp > XB_SPIN_CAP) { atomicAdd(&bar[XB_TMO], 1u); break; } }
  }
  nloc = mine > 0u ? mine : 1u; nx = cnt > 0u ? cnt : 1u;
}
DI void xcd_barrier(unsigned* bar, volatile LAS unsigned* st) {
  asm volatile("s_waitcnt vmcnt(0)" ::: "memory");
  __syncthreads();
  if (threadIdx.x == 0) {
    const unsigned x = xb_xcc_id();
    __builtin_amdgcn_s_waitcnt(0);
    unsigned nloc = st[0], nx = st[1];
    if (nloc == 0u) { xcd_barrier_complete(bar, x, nloc, nx); st[0] = nloc; st[1] = nx; }
    const unsigned old = xb_add(&bar[XB_XSUB(x)], 1u);
    const unsigned gen = old / nloc;
    if (old + 1u == (gen + 1u) * nloc) {
      __builtin_amdgcn_fence(__ATOMIC_RELEASE, "agent");
      asm volatile("s_waitcnt vmcnt(0)" ::: "memory");
      const unsigned og = xb_add(&bar[XB_TOP], 1u);
      const unsigned tg = og / nx;
      if (og + 1u == (tg + 1u) * nx) xb_add(&bar[XB_TOPGEN], 1u);
      else XB_SPIN(xb_ld(&bar[XB_TOPGEN]) == tg, bar);
      __builtin_amdgcn_fence(__ATOMIC_ACQUIRE, "agent");
      xb_add(&bar[XB_XGEN(x)], 1u);
      asm volatile("s_waitcnt vmcnt(0)" ::: "memory");
    } else {
      XB_SPIN(xb_ld(&bar[XB_XGEN(x)]) == gen, bar);
      __builtin_amdgcn_fence(__ATOMIC_ACQUIRE, "agent");
      asm volatile("s_waitcnt vmcnt(0)" ::: "memory");
    }
  }
  __syncthreads();
}

#ifndef MINW
#define MINW 2
#endif
__global__ void __launch_bounds__(NTHR, 2) hybrid_encoder_mega(Params P) {
  cg::grid_group grid = cg::this_grid();
  extern __shared__ __attribute__((aligned(16))) unsigned char smem[];
  __shared__ int s_item;
  __shared__ unsigned s_bar_target;
  __shared__ __attribute__((aligned(16))) unsigned xb_words[4];
  if (threadIdx.x == 0) { s_bar_target = 0u; xb_words[0] = 0u; xb_words[1] = 0u; xb_words[2] = 0u; xb_words[3] = 0u; }
  __syncthreads();
  const int G = P.G, TG = G * SEQ, mtiles = TG / 256;
#define WSP ws_ptrs(P.ws, launder_s(P.G))
  const int ngroups = NBATCH / G;

  if (PH(0)) phase_convert(P, WSP, smem);
  grid.sync();

  xcd_barrier_post(WSP.xbar);
  int phase_ctr = 0;
  for (int grp = 0; grp < ngroups; ++grp) {
    for (int layer = 0; layer < NLAYER; ++layer) {
      const size_t tok0 = (size_t)grp * TG;
      const float* xin = (layer == 0 ? P.in[I_X] : P.out) + tok0 * 1024;
      float* xo = P.out + tok0 * 1024;
      if (layer == 0) { const WsPtrs W = WSP; phase_rowprep(xin, W.XB, W.SSA, TG); xcd_barrier(WSP.xbar, (volatile LAS unsigned*)xb_words); }
      for (int rep = 0; rep < DUP(2); ++rep)
      for (int t = blockIdx.x; t < mtiles * 51; t += gridDim.x) { int mt, nt; tile_map(t, mtiles, mt, nt); if (PH(2)) inproj_tile8(P, WSP, layer, mt, nt, smem); }
      xcd_barrier(WSP.xbar, (volatile LAS unsigned*)xb_words);
      {
        int* ctr3 = WSP.cnt + 32 + phase_ctr;
        const int total3 = mtiles * 14 + G * 128;
        while (true) {
          __syncthreads();
          if (get_tid() == 0) s_item = atomicAdd(ctr3, 1);
          __syncthreads();
          const int t = s_item;
          if (t >= total3) break;
          if (t < mtiles * 14) { if (PH(3)) mla_up_tile8(WSP, layer, t, mtiles, smem); } else ret_kv_item(WSP, t - mtiles * 14, smem);
        }
      }
      xcd_barrier(WSP.xbar, (volatile LAS unsigned*)xb_words);
      if (PH(4)) { ret_state_scan(WSP, G); mla_prep(P, WSP, layer, TG); p_convert(P.in[I_P] + ((size_t)layer * TT + tok0) * 256, WSP.PB, TG * 32); }
      xcd_barrier(WSP.xbar, (volatile LAS unsigned*)xb_words);
      {
        int* c8 = WSP.cnt + 64 + phase_ctr * 8; phase_ctr++;
        const int l_lru = G * 2, l_mla = G * 16, l_diff = G * 32, l_ret = G * 16;
        const int per = l_lru + l_mla + l_diff + l_ret;
        const int myx = (int)xb_xcc_id() & 7;
        for (int q8 = 0; q8 < 8; ++q8) {
          const int xq = (myx + q8) & 7;
          while (true) {
            __syncthreads();
            if (get_tid() == 0) s_item = atomicAdd(c8 + xq, 1);
            __syncthreads();
            const int j = s_item;
            if (j >= per) break;
            if (j < l_lru) { if (PH(5)) lru_item(P, WSP, layer, j * 8 + xq, smem); }
            else if (j < l_lru + l_mla) { const int u = j - l_lru; if (PH(6)) mla_attn_item(WSP, P.in[I_MQG] + layer * 192, P.in[I_MKG] + layer * 192, (((u >> 4) * 8 + xq) << 4) | (u & 15), smem); }
            else if (j < l_lru + l_mla + l_diff) { const int u = j - l_lru - l_mla; if (PH(8)) diff_attn_item(P, WSP, layer, (((u >> 5) * 8 + xq) << 5) | (u & 31), smem); }
            else { const int u = j - l_lru - l_mla - l_diff; if (PH(7)) ret_attn_item(P, WSP, layer, (((u >> 4) * 8 + xq) << 4) | (u & 15), smem); }
          }
        }
      }
      xcd_barrier(WSP.xbar, (volatile LAS unsigned*)xb_words);
      for (int t = blockIdx.x; t < mtiles * 4; t += gridDim.x) { int mt, nt; tile_map(t, mtiles, mt, nt); if (PH(9)) branch_tile8(P, WSP, layer, mt, nt, smem); }
      xcd_barrier(WSP.xbar, (volatile LAS unsigned*)xb_words);
      for (int t = blockIdx.x; t < mtiles * 4; t += gridDim.x) { int mt, nt; tile_map(t, mtiles, mt, nt); if (PH(10)) wout_tile8(WSP, layer, xin, xo, mt, nt, smem); }
      xcd_barrier(WSP.xbar, (volatile LAS unsigned*)xb_words);
      for (int rep = 0; rep < DUP(11); ++rep)
      for (int t = blockIdx.x; t < mtiles * 20; t += gridDim.x) { int mt, nt; if (t < mtiles * 16) { tile_map(t, mtiles, mt, nt); if (PH(11)) ffn1_tile8(WSP, layer, mt, nt, smem); } else { tile_map(t - mtiles * 16, mtiles, mt, nt); pp_tile8(WSP, layer, mt, nt, smem); } }
      xcd_barrier(WSP.xbar, (volatile LAS unsigned*)xb_words);
      for (int t = blockIdx.x; t < mtiles * 4; t += gridDim.x) { int mt, nt; tile_map(t, mtiles, mt, nt); if (PH(12)) ffn2_tile8(WSP, layer, xo, mt, nt, smem); }
      xcd_barrier(WSP.xbar, (volatile LAS unsigned*)xb_words);
      const float* pin = P.in[I_P] + ((size_t)layer * TT + tok0) * 256;
      for (int t = blockIdx.x; t < mtiles * 4; t += gridDim.x) { int mt, nt; tile_map(t, mtiles, mt, nt); if (PH(13)) ple_tile8(WSP, layer, xo, mt, nt, smem); }
      xcd_barrier(WSP.xbar, (volatile LAS unsigned*)xb_words);
    }
  }
}

extern "C" void kernel_launch(void* const* d_in, const int* in_sizes, int n_in, void* d_out, int out_size, void* d_ws,
                              size_t ws_size, hipStream_t stream) {
  static int grid_blocks = 0;
  if (!grid_blocks) {
    int dev = 0, cus = 0, per_cu = 0;
    hipGetDevice(&dev);
    hipDeviceGetAttribute(&cus, hipDeviceAttributeMultiprocessorCount, dev);
    hipFuncSetAttribute((const void*)hybrid_encoder_mega, hipFuncAttributeMaxDynamicSharedMemorySize, SMEM_BYTES);
    hipOccupancyMaxActiveBlocksPerMultiprocessor(&per_cu, hybrid_encoder_mega, NTHR, SMEM_BYTES);
    if (per_cu > 1) per_cu = 1;
    if (per_cu < 1) per_cu = 1;
    grid_blocks = cus * per_cu;
  }
  Params p{};
  for (int i = 0; i < 34; ++i) p.in[i] = (const float*)d_in[i];
  p.out = (float*)d_out;
  p.ws = (unsigned char*)d_ws;
  int G = 4;
  while (G > 1 && ws_need(G) > ws_size) G >>= 1;
  p.G = G;
  p.pad = 0;
  void* args[] = {&p};
  hipError_t e = hipLaunchCooperativeKernel((void*)hybrid_encoder_mega, dim3(grid_blocks), dim3(NTHR), args, SMEM_BYTES, stream);
  if (e != hipSuccess) fprintf(stderr, "cooperative launch failed: %s (grid %d)\n", hipGetErrorString(e), grid_blocks);
}
```

```cpp
#include <hip/hip_runtime.h>
#include <hip/hip_cooperative_groups.h>
#include <cstdio>
namespace cg = cooperative_groups;

typedef unsigned short u16;
typedef unsigned int u32;
typedef short bf16x8 __attribute__((ext_vector_type(8)));
typedef float f32x16 __attribute__((ext_vector_type(16)));
typedef __bf16 bf2_t __attribute__((ext_vector_type(2)));
typedef float f2_t __attribute__((ext_vector_type(2)));
typedef u32 u32x4 __attribute__((ext_vector_type(4)));
typedef u32 u32x2 __attribute__((ext_vector_type(2)));
typedef float f32x4 __attribute__((ext_vector_type(4)));

#define DI __device__ __forceinline__
#define MFMA32(a, b, c) __builtin_amdgcn_mfma_f32_32x32x16_bf16((a), (b), (c), 0, 0, 0)

constexpr int SEQ = 4096, NBATCH = 16, TT = NBATCH * SEQ, NLAYER = 2;
constexpr int LDY = 13056;
constexpr int O_AX = 0, O_AG = 1024, O_BQ = 2048, O_BK = 3072, O_BV = 4096, O_DV = 5120, O_DQ = 6144,
              O_DK = 6656, O_DG = 7168, O_GT = 8192, O_CQ = 12288, O_CKV = 12672, O_KPE = 12928, O_END = 12992;
constexpr float EPSV = 1e-6f;
constexpr float LOG2E = 1.4426950408889634f;
constexpr size_t W_IN = 0, W_UQ = 13369344, W_UKV = 13959168, W_BR = 14483456, W_OUT = 18677760,
                 W_FF1 = 19726336, W_FF2 = 23920640, W_PG = 28114944, W_PE = 29163520, W_LAYER = 29425664;
constexpr int CONV_TILES = 7184;
constexpr int NTHR = 512;
constexpr int SMEM_BYTES = 149504;
constexpr int RS_OFF = 147456;
#ifndef PHMASK
#define PHMASK 0xffff
#endif
#define PH(k) ((PHMASK >> (k)) & 1)
#ifndef DUPMASK
#define DUPMASK 0
#endif
#define DUP(k) (1 + ((DUPMASK >> (k)) & 1))

struct Params {
  const float* in[34];
  float* out;
  unsigned char* ws;
  int G;
  int pad;
};
enum { I_X = 0, I_P, I_N1G, I_WIN, I_GATEB, I_CONVW, I_CONVB, I_WA, I_BA, I_WX, I_BX, I_LAM, I_DQG, I_DKG, I_DLAM,
       I_DSUBG, I_QAG, I_WUQ, I_KVAG, I_WUKV, I_MQG, I_MKG, I_GNG, I_WBRA, I_WBRB, I_WBRC, I_WBRD, I_WOUT, I_N2G,
       I_WFF1, I_WFF2, I_N3G, I_WPG, I_WPE };

struct WsPtrs {
  unsigned* xbar; int* cnt; float* rope; u16* W; float* rinv; u16* Y; u16* XB; u16* MERGED; float* HF; u16* BVT; u16* DVT; u16* CVT;
  u16* QC; u16* KC; u16* YMIX; u16* H1; u16* XB2; float* SSA; float* SSB; float* SSC; u16* PB; u16* PF; float* KVS;
};
__host__ __device__ inline size_t ws_need(int G) {
  size_t TG = (size_t)G * SEQ;
  size_t b = 24576 + (size_t)NLAYER * W_LAYER * 2 + TG * 4 + 256;
  b += TG * LDY * 2;
  b += TG * 1024 * 2 * 2;
  b += TG * 1024 * 2 * 3;
  b += TG * 1536 * 2 * 2;
  b += TG * 4096 * 2;
  b += TG * 1024 * 2 + 3 * TG * 64;
  b += TG * 256 * 2;
  b += (size_t)G * 8 * 16 * 2 * 8192 * 2;
  return b + 4096;
}
DI WsPtrs ws_ptrs(unsigned char* ws, int G) {
  WsPtrs p; size_t TG = (size_t)G * SEQ; size_t o = 0;
  p.cnt = (int*)(ws + o); o += 4096;
  p.xbar = (unsigned*)(ws + o); o += 16384;
  p.rope = (float*)(ws + o); o += 4096;
  p.W = (u16*)(ws + o); o += (size_t)NLAYER * W_LAYER * 2;
  p.rinv = (float*)(ws + o); o += TG * 4 + 256;
  p.Y = (u16*)(ws + o); p.H1 = p.Y; o += TG * LDY * 2;
  p.XB = (u16*)(ws + o); p.HF = (float*)(ws + o); o += TG * 1024 * 2;
  p.MERGED = (u16*)(ws + o); o += TG * 1024 * 2;
  p.BVT = (u16*)(ws + o); o += TG * 1024 * 2;
  p.DVT = (u16*)(ws + o); o += TG * 1024 * 2;
  p.CVT = (u16*)(ws + o); o += TG * 1024 * 2;
  p.QC = (u16*)(ws + o); o += TG * 1536 * 2;
  p.KC = (u16*)(ws + o); o += TG * 1536 * 2;
  p.YMIX = (u16*)(ws + o); o += TG * 4096 * 2;
  p.XB2 = (u16*)(ws + o); o += TG * 1024 * 2;
  p.SSA = (float*)(ws + o); o += TG * 64;
  p.SSB = (float*)(ws + o); o += TG * 64;
  p.SSC = (float*)(ws + o); o += TG * 64;
  p.PB = (u16*)(ws + o); o += TG * 256 * 2;
  p.PF = (u16*)(ws + o); o += (size_t)G * 8 * 16 * 2 * 8192 * 2;
  p.KVS = p.HF;
  return p;
}

DI u32 pack2(float a, float b) { f2_t v = {a, b}; bf2_t r = __builtin_convertvector(v, bf2_t); return __builtin_bit_cast(u32, r); }
DI float bflo(u32 v) { return __uint_as_float(v << 16); }
DI float bfhi(u32 v) { return __uint_as_float(v & 0xffff0000u); }
DI int lane_id_l() { int l = __builtin_amdgcn_mbcnt_hi(-1, __builtin_amdgcn_mbcnt_lo(-1, 0)); asm volatile("" : "+v"(l)); return l; }
DI float shx(float v, int k) { return __int_as_float(__builtin_amdgcn_ds_bpermute((lane_id_l() ^ k) << 2, __float_as_int(v))); }
DI float wave_sum(float v) {
#pragma unroll
  for (int o = 32; o > 0; o >>= 1) v += shx(v, o);
  return v;
}
DI float sigmoidf_(float x) { return __builtin_amdgcn_rcpf(1.f + __builtin_amdgcn_exp2f(-LOG2E * x)); }
DI float gelu_tanh(float x) { float z = 0.7978845608028654f * (x + 0.044715f * x * x * x); float t = 1.f - 2.f * __builtin_amdgcn_rcpf(__builtin_amdgcn_exp2f(2.f * LOG2E * z) + 1.f); return 0.5f * x * (1.f + t); }
DI int get_tid() { int t = threadIdx.x; asm volatile("" : "+v"(t)); return t; }
DI int launder_s(int v) { asm volatile("" : "+s"(v)); return v; }
DI int crow(int e, int h) { return (e & 3) + 8 * (e >> 2) + 4 * h; }
DI void rot_cs(float pos, float frev, float& c, float& s) {
  float rev = pos * frev; rev -= floorf(rev);
  c = __builtin_amdgcn_cosf(rev); s = __builtin_amdgcn_sinf(rev);
}
DI int vperm(int s) { return (s & ~12) | ((s & 4) << 1) | ((s & 8) >> 1); }

DI void tile_map(int idx, int mtiles, int& mt, int& nt) {
  int xcd = idx & 7, j = idx >> 3, mper = mtiles >> 3;
  mt = xcd * mper + (j % mper); nt = j / mper;
}

template <bool SWAP, int NJ, bool AF32>
DI void gemm_main(const void* Ap, int lda, const u16* Bt, int ldb, int K, int m0, int n0, f32x16 (&acc)[2][NJ], unsigned char* smem) {
  constexpr int BN = 64 * NJ;
  constexpr int STG = (256 + BN) * 72;
  u16* S0 = (u16*)smem;
  const int tid = get_tid(), lane = tid & 63, w = tid >> 6, r = lane & 31, h = lane >> 5, wm = w >> 1, wn = w & 1;
  u32x4 ra[AF32 ? 8 : 4];
  u32x4 rb[NJ];
  const int crow_ = tid >> 3, ckc = tid & 7;
  const u32 aoffb = (u32)(crow_ * lda + 8 * ckc) * (AF32 ? 4u : 2u);
  const u32 boffb = (u32)(crow_ * ldb + 8 * ckc) * 2u;
  const char* Abase = (const char*)Ap + (size_t)m0 * lda * (AF32 ? 4 : 2);
  const char* Bbase = (const char*)Bt + (size_t)n0 * ldb * 2;
  auto gload = [&](int k0) __attribute__((always_inline)) {
    if constexpr (AF32) {
#pragma unroll
      for (int i = 0; i < 4; ++i) {
        const char* p = Abase + ((size_t)i * 64 * lda + k0) * 4 + aoffb;
        ra[2 * i] = *(const u32x4*)p; ra[2 * i + 1] = *(const u32x4*)(p + 16);
      }
    } else {
#pragma unroll
      for (int i = 0; i < 4; ++i) ra[i] = *(const u32x4*)(Abase + ((size_t)i * 64 * lda + k0) * 2 + aoffb);
    }
#pragma unroll
    for (int i = 0; i < NJ; ++i) rb[i] = *(const u32x4*)(Bbase + ((size_t)i * 64 * ldb + k0) * 2 + boffb);
  };
  auto lstore = [&](int b) __attribute__((always_inline)) {
    u16* As = S0 + b * STG;
    u16* Bs = As + 256 * 72;
    if constexpr (AF32) {
#pragma unroll
      for (int i = 0; i < 4; ++i) {
        u32x4 a = ra[2 * i], bb = ra[2 * i + 1], o;
        o.x = pack2(__uint_as_float(a.x), __uint_as_float(a.y)); o.y = pack2(__uint_as_float(a.z), __uint_as_float(a.w));
        o.z = pack2(__uint_as_float(bb.x), __uint_as_float(bb.y)); o.w = pack2(__uint_as_float(bb.z), __uint_as_float(bb.w));
        *(u32x4*)(As + (crow_ + 64 * i) * 72 + 8 * ckc) = o;
      }
    } else {
#pragma unroll
      for (int i = 0; i < 4; ++i) *(u32x4*)(As + (crow_ + 64 * i) * 72 + 8 * ckc) = ra[i];
    }
#pragma unroll
    for (int i = 0; i < NJ; ++i) *(u32x4*)(Bs + (crow_ + 64 * i) * 72 + 8 * ckc) = rb[i];
  };
  const int nk = K >> 6;
  gload(0);
  __syncthreads();
  lstore(0);
  if (nk > 1) gload(64);
  __syncthreads();
#pragma unroll 1
  for (int t = 0; t < nk; ++t) {
    const u16* As = S0 + (t & 1) * STG;
    const u16* Bs = As + 256 * 72;
#pragma unroll
    for (int ks = 0; ks < 4; ++ks) {
      bf16x8 af[2], bf[NJ];
#pragma unroll
      for (int im = 0; im < 2; ++im) af[im] = *(const bf16x8*)(As + (64 * wm + 32 * im + r) * 72 + 16 * ks + 8 * h);
#pragma unroll
      for (int jn = 0; jn < NJ; ++jn) bf[jn] = *(const bf16x8*)(Bs + (32 * NJ * wn + 32 * jn + r) * 72 + 16 * ks + 8 * h);
#pragma unroll
      for (int im = 0; im < 2; ++im)
#pragma unroll
        for (int jn = 0; jn < NJ; ++jn)
          acc[im][jn] = SWAP ? MFMA32(bf[jn], af[im], acc[im][jn]) : MFMA32(af[im], bf[jn], acc[im][jn]);
    }
    if (t + 1 < nk) lstore((t + 1) & 1);
    if (t + 2 < nk) gload((t + 2) * 64);
    __syncthreads();
  }
}
template <int NJ>
DI void acc_zero(f32x16 (&acc)[2][NJ]) {
#pragma unroll
  for (int im = 0; im < 2; ++im)
#pragma unroll
    for (int jn = 0; jn < NJ; ++jn)
#pragma unroll
      for (int e = 0; e < 16; ++e) acc[im][jn][e] = 0.f;
}

template <int NJ>
DI void store_sw_bf16(const f32x16 (&acc)[2][NJ], u16* dst, int ld, int mrow0  , int ncol0  , int h, int nlimit) {
#pragma unroll
  for (int im = 0; im < 2; ++im) {
    u16* rowp = dst + (size_t)(mrow0 + 32 * im) * ld;
#pragma unroll
    for (int jn = 0; jn < NJ; ++jn)
#pragma unroll
      for (int g = 0; g < 4; ++g) {
        int n = ncol0 + 32 * jn + 8 * g + 4 * h;
        if (n < nlimit) {
          u32x2 o; o.x = pack2(acc[im][jn][4 * g], acc[im][jn][4 * g + 1]); o.y = pack2(acc[im][jn][4 * g + 2], acc[im][jn][4 * g + 3]);
          *(u32x2*)(rowp + n) = o;
        }
      }
  }
}
DI void store_vT(const f32x16 (&acc)[2][4], u16* vT, const float* rs, int mbase  , int nrel0  , int r, int h) {
#pragma unroll
  for (int im = 0; im < 2; ++im)
#pragma unroll
    for (int g = 0; g < 4; ++g) {
      int m = mbase + 32 * im + 8 * g + 4 * h;
      f32x4 sc = *(const f32x4*)(rs + m);
      int bl = m >> 12, s = m & 4095, sp = vperm(s);
#pragma unroll
      for (int jn = 0; jn < 4; ++jn) {
        int nrel = nrel0 + 32 * jn + r; int hh = nrel >> 7, dv = nrel & 127;
        u32x2 o; o.x = pack2(acc[im][jn][4 * g] * sc.x, acc[im][jn][4 * g + 1] * sc.y);
        o.y = pack2(acc[im][jn][4 * g + 2] * sc.z, acc[im][jn][4 * g + 3] * sc.w);
        *(u32x2*)(vT + ((size_t)((bl * 8 + hh) * 128 + dv)) * 4096 + sp) = o;
      }
    }
}

DI int inmap(int n) {
  if (n < 5120) return n;
  if (n < 6144) return n - 5120 + 6848;
  if (n < 6656) return n - 6144 + 5824;
  if (n < 7168) return n - 6656 + 6336;
  if (n < 8192) return n - 7168 + 7872;
  if (n < 12288) return n - 8192 + 8896;
  if (n < 12672) return n - 12288 + 5120;
  if (n < 12928) return n - 12672 + 5504;
  if (n < 12992) return n - 12928 + 5760;
  return -1;
}
DI void conv_tile(const float* src, int ld, int srccol0, int k0, const float* gain, u16* dst, int ldd, int n0, float* sm) {
  const int tid = get_tid(), tx = tid & 15, ty = tid >> 4;
#pragma unroll
  for (int i = 0; i < 2; ++i) {
    int k = ty + 32 * i;
    f32x4 v = f32x4{0.f, 0.f, 0.f, 0.f};
    if (srccol0 >= 0) v = *(const f32x4*)(src + (size_t)(k0 + k) * ld + srccol0 + 4 * tx);
    float g = gain ? gain[k0 + k] : 1.f;
    float* d = sm + k * 65 + 4 * tx;
    d[0] = v.x * g; d[1] = v.y * g; d[2] = v.z * g; d[3] = v.w * g;
  }
  __syncthreads();
  {
    int n = tid >> 3, ks = (tid & 7) * 8;
    u32 o[4];
#pragma unroll
    for (int j = 0; j < 4; ++j) o[j] = pack2(sm[(ks + 2 * j) * 65 + n], sm[(ks + 2 * j + 1) * 65 + n]);
    u16* d = dst + (size_t)(n0 + n) * ldd + k0 + ks;
    *(u32x4*)d = u32x4{o[0], o[1], o[2], o[3]};
  }
  __syncthreads();
}
DI void phase_convert(const Params& P, const WsPtrs& W, unsigned char* smem) {
  float* sm = (float*)smem;
  for (int t = blockIdx.x; t < NLAYER * CONV_TILES; t += gridDim.x) {
    int layer = t / CONV_TILES, u = t % CONV_TILES;
    u16* wl = W.W + (size_t)layer * W_LAYER;
    const float* src; const float* gain = nullptr; u16* dst; int K, ld, ntiles, kind = 0;
    if (u < 3264) { src = P.in[I_WIN] + (size_t)layer * 1024 * 12992; gain = P.in[I_N1G] + layer * 1024; dst = wl + W_IN; K = 1024; ld = 12992; ntiles = 204; kind = 1; }
    else if (u < 3408) { u -= 3264; src = P.in[I_WUQ] + (size_t)layer * 384 * 1536; gain = P.in[I_QAG] + layer * 384; dst = wl + W_UQ; K = 384; ld = 1536; ntiles = 24; }
    else if (u < 3536) { u -= 3408; src = P.in[I_WUKV] + (size_t)layer * 256 * 2048; gain = P.in[I_KVAG] + layer * 256; dst = wl + W_UKV; K = 256; ld = 2048; ntiles = 32; kind = 2; }
    else if (u < 4560) { u -= 3536; int j = u >> 8; u &= 255; src = P.in[I_WBRA + j] + (size_t)layer * 1048576; dst = wl + W_BR + (size_t)j * 1048576; K = 1024; ld = 1024; ntiles = 16; }
    else if (u < 4816) { u -= 4560; src = P.in[I_WOUT] + (size_t)layer * 1048576; dst = wl + W_OUT; K = 1024; ld = 1024; ntiles = 16; }
    else if (u < 5840) { u -= 4816; src = P.in[I_WFF1] + (size_t)layer * 4194304; gain = P.in[I_N2G] + layer * 1024; dst = wl + W_FF1; K = 1024; ld = 4096; ntiles = 64; }
    else if (u < 6864) { u -= 5840; src = P.in[I_WFF2] + (size_t)layer * 4194304; dst = wl + W_FF2; K = 4096; ld = 1024; ntiles = 16; }
    else if (u < 7120) { u -= 6864; src = P.in[I_WPG] + (size_t)layer * 1048576; gain = P.in[I_N3G] + layer * 1024; dst = wl + W_PG; K = 1024; ld = 1024; ntiles = 16; }
    else { u -= 7120; src = P.in[I_WPE] + (size_t)layer * 262144; dst = wl + W_PE; K = 256; ld = 1024; ntiles = 16; }
    int kt = u / ntiles, nt = u % ntiles, n0 = nt * 64, sc = n0;
    if (kind == 1) sc = inmap(n0);
    else if (kind == 2) { int hh = (n0 & 1023) >> 7, c = n0 & 127; sc = hh * 256 + c + (n0 >= 1024 ? 128 : 0); }
    conv_tile(src, ld, sc, kt * 64, gain, dst, K, n0, sm);
  }
  if (blockIdx.x == 0) {
    for (int i = get_tid(); i < 1024; i += NTHR) W.cnt[i] = 0;
    for (int i = get_tid(); i < 4096; i += NTHR) W.xbar[i] = 0u;
    if (get_tid() < 72) {
      int i = get_tid(); double theta, rot; int j;
      if (i < 8) { theta = 500000.0; rot = 16.0; j = i; }
      else if (i < 40) { theta = 500000.0; rot = 64.0; j = i - 8; }
      else { theta = 10000.0; rot = 64.0; j = i - 40; }
      double invf = exp2(-(2.0 * j / rot) * log2(theta));
      W.rope[i] = (float)(invf / 6.283185307179586476925);
    }
  }
}

DI void phase_rowprep(const float* x, u16* xb, float* rinv, int nrows) {
  const int lane = get_tid() & 63, w = get_tid() >> 6;
  for (int row = blockIdx.x * 8 + w; row < nrows; row += gridDim.x * 8) {
    const float* xr = x + (size_t)row * 1024;
    f32x4 v[4]; float ss = 0.f;
#pragma unroll
    for (int i = 0; i < 4; ++i) { v[i] = *(const f32x4*)(xr + 256 * i + 4 * lane); ss += v[i].x * v[i].x + v[i].y * v[i].y + v[i].z * v[i].z + v[i].w * v[i].w; }
    ss = wave_sum(ss);
    if (lane == 0) rinv[row * 16] = ss;
#pragma unroll
    for (int i = 0; i < 4; ++i) { u32x2 o; o.x = pack2(v[i].x, v[i].y); o.y = pack2(v[i].z, v[i].w); *(u32x2*)(xb + (size_t)row * 1024 + 256 * i + 4 * lane) = o; }
  }
}

DI void tile_rinv(const float* ssp, int np, int m0, float* rs) {
  const int tid = get_tid(), row = tid >> 1, half = tid & 1;
  __syncthreads();
  const float* p = ssp + (size_t)(m0 + row) * 16;
  float ss = 0.f;
  if (np == 1) { ss = half ? 0.f : p[0]; }
  else { const int hn = np >> 1; for (int i = 0; i < hn; ++i) ss += p[half * hn + i]; }
  ss += shx(ss, 1);
  if (half == 0) rs[row] = rsqrtf(ss * (1.f / 1024.f) + EPSV);
}
DI void inproj_qk_sub(const Params& P, const WsPtrs& W, int layer, int m0, int n0, unsigned char* smem) {
  const int tid = get_tid(), lane = tid & 63, w = tid >> 6, r = lane & 31, h = lane >> 5, wm = w >> 1, wn = w & 1;
  float* rs = (float*)(smem + RS_OFF);
  tile_rinv(W.SSA, layer == 0 ? 1 : 16, m0, rs);
  const u16* Bt = W.W + (size_t)layer * W_LAYER + W_IN;
  f32x16 acc[2][2];
  acc_zero<2>(acc);
  gemm_main<true, 2, false>(W.XB, 1024, Bt, 1024, 1024, m0, n0, acc, smem);
  const int nw0 = n0 + 64 * wn;
  const int mrow0 = m0 + 64 * wm + r;
#pragma unroll
  for (int im = 0; im < 2; ++im) {
    float rv = rs[64 * wm + r + 32 * im];
#pragma unroll
    for (int jn = 0; jn < 2; ++jn)
#pragma unroll
      for (int e = 0; e < 16; ++e) acc[im][jn][e] *= rv;
  }
  if (nw0 < O_BV) {
    const bool isq = nw0 < O_BK;
    const float* gp = (isq ? P.in[I_DQG] : P.in[I_DKG]) + layer * 64;
    const float qs = isq ? 0.125f * LOG2E : 1.f;
#pragma unroll
    for (int im = 0; im < 2; ++im) {
      float pos = (float)((mrow0 + 32 * im) & 4095);
      float ss = 0.f;
#pragma unroll
      for (int jj = 0; jj < 2; ++jj)
#pragma unroll
        for (int e = 0; e < 16; ++e) ss += acc[im][jj][e] * acc[im][jj][e];
      ss += shx(ss, 32);
      float sc = rsqrtf(ss * (1.f / 64.f) + EPSV) * qs;
#pragma unroll
      for (int jj = 0; jj < 2; ++jj)
#pragma unroll
        for (int g = 0; g < 4; ++g) {
          f32x4 g4 = *(const f32x4*)(gp + 32 * jj + 8 * g + 4 * h);
          acc[im][jj][4 * g] *= sc * g4.x; acc[im][jj][4 * g + 1] *= sc * g4.y; acc[im][jj][4 * g + 2] *= sc * g4.z; acc[im][jj][4 * g + 3] *= sc * g4.w;
        }
#pragma unroll
      for (int e = 0; e < 4; ++e) {
        float c, sn; rot_cs(pos, W.rope[e + 4 * h], c, sn);
        float x1 = acc[im][0][e], x2 = acc[im][0][e + 4];
        acc[im][0][e] = x1 * c - x2 * sn;
        acc[im][0][e + 4] = x2 * c + x1 * sn;
      }
    }
  } else {
    const float ksc = (nw0 < O_DK) ? 1.f : 0.125f;
#pragma unroll
    for (int e = 0; e < 16; ++e) {
      float fr = W.rope[40 + crow(e, h)];
#pragma unroll
      for (int im = 0; im < 2; ++im) {
        float pos = (float)((mrow0 + 32 * im) & 4095);
        float c, sn; rot_cs(pos, fr, c, sn);
        float x1 = acc[im][0][e], x2 = acc[im][1][e];
        acc[im][0][e] = (x1 * c - x2 * sn) * ksc;
        acc[im][1][e] = (x2 * c + x1 * sn) * ksc;
      }
    }
  }
  store_sw_bf16<2>(acc, W.Y, LDY, mrow0, nw0, h, 1 << 30);
}

DI void inproj_tile(const Params& P, const WsPtrs& W, int layer, int mt, int nt, unsigned char* smem) {
  const int m0 = mt * 256, n0 = nt * 256;
  if ((n0 >= O_BQ && n0 < O_BV) || (n0 >= O_DQ && n0 < O_DG)) {
    inproj_qk_sub(P, W, layer, m0, n0, smem);
    inproj_qk_sub(P, W, layer, m0, n0 + 128, smem);
    return;
  }
  const int tid = get_tid(), lane = tid & 63, w = tid >> 6, r = lane & 31, h = lane >> 5, wm = w >> 1, wn = w & 1;
  const u16* Bt = W.W + (size_t)layer * W_LAYER + W_IN;
  float* rs = (float*)(smem + RS_OFF);
  tile_rinv(W.SSA, layer == 0 ? 1 : 16, m0, rs);
  f32x16 acc[2][4];
  acc_zero<4>(acc);
  const bool vsec = (n0 >= O_BV && n0 < O_DQ);
  if (vsec) {
    gemm_main<false, 4, false>(W.XB, 1024, Bt, 1024, 1024, m0, n0, acc, smem);
    int nw0 = n0 + 128 * wn;
    u16* vT = (nw0 < O_DV) ? W.BVT : W.DVT;
    int nrel0 = (nw0 < O_DV) ? nw0 - O_BV : nw0 - O_DV;
    store_vT(acc, vT, rs - m0, m0 + 64 * wm, nrel0, r, h);
    return;
  }
  gemm_main<true, 4, false>(W.XB, 1024, Bt, 1024, 1024, m0, n0, acc, smem);
  const int nw0 = n0 + 128 * wn;
  const int mrow0 = m0 + 64 * wm + r;
#pragma unroll
  for (int im = 0; im < 2; ++im) {
    float rv = rs[64 * wm + r + 32 * im];
#pragma unroll
    for (int jn = 0; jn < 4; ++jn)
#pragma unroll
      for (int e = 0; e < 16; ++e) acc[im][jn][e] *= rv;
  }
  store_sw_bf16<4>(acc, W.Y, LDY, mrow0, nw0, h, O_END);
}

DI void mla_up_tile(const WsPtrs& W, int layer, int item, int mtiles, unsigned char* smem) {
  const int tid = get_tid(), lane = tid & 63, w = tid >> 6, r = lane & 31, h = lane >> 5, wm = w >> 1, wn = w & 1;
  const bool isq = item < mtiles * 6;
  int mt, nt;
  if (isq) { mt = item / 6; nt = item % 6; } else { int u = item - mtiles * 6; mt = u >> 3; nt = u & 7; }
  const int m0 = mt * 256, n0 = nt * 256;
  const int K = isq ? 384 : 256;
  const u16* A = W.Y + (isq ? O_CQ : O_CKV);
  const u16* Bt = W.W + (size_t)layer * W_LAYER + (isq ? W_UQ : W_UKV);
  float* rs = (float*)(smem + RS_OFF);
  __syncthreads();
  {
    int row = tid >> 1, half = tid & 1, kh = K >> 1;
    const u16* p = A + (size_t)(m0 + row) * LDY + half * kh;
    float ss = 0.f;
    for (int c = 0; c < kh; c += 8) {
      u32x4 v = *(const u32x4*)(p + c);
      float a;
      a = bflo(v.x); ss += a * a; a = bfhi(v.x); ss += a * a; a = bflo(v.y); ss += a * a; a = bfhi(v.y); ss += a * a;
      a = bflo(v.z); ss += a * a; a = bfhi(v.z); ss += a * a; a = bflo(v.w); ss += a * a; a = bfhi(v.w); ss += a * a;
    }
    ss += shx(ss, 1);
    if (half == 0) rs[row] = rsqrtf(ss / (float)K + EPSV);
  }
  f32x16 acc[2][4];
  acc_zero<4>(acc);
  const bool vsec = (!isq) && nt >= 4;
  if (vsec) {
    gemm_main<false, 4, false>(A, LDY, Bt, K, K, m0, n0, acc, smem);
    store_vT(acc, W.CVT, rs - m0, m0 + 64 * wm, (n0 - 1024) + 128 * wn, r, h);
    return;
  }
  gemm_main<true, 4, false>(A, LDY, Bt, K, K, m0, n0, acc, smem);
  const int mrow0 = m0 + 64 * wm + r;
#pragma unroll
  for (int im = 0; im < 2; ++im) {
    float rv = rs[64 * wm + r + 32 * im];
#pragma unroll
    for (int jn = 0; jn < 4; ++jn)
#pragma unroll
      for (int e = 0; e < 16; ++e) acc[im][jn][e] *= rv;
  }
  const int nw0 = n0 + 128 * wn;
  if (isq) {
    store_sw_bf16<4>(acc, W.QC, 1536, mrow0, nw0, h, 1 << 30);
  } else {
    int hh = nw0 >> 7;
    store_sw_bf16<4>(acc, W.KC + hh * 192, 1536, mrow0, 0, h, 1 << 30);
  }
}

DI void mla_prep(const Params& P, const WsPtrs& W, int layer, int TG) {
  const int nrows = TG * 8;
  for (int base = blockIdx.x * 256; base < nrows; base += gridDim.x * 256) {
    int row = base + (get_tid() >> 1), half = get_tid() & 1;
    bool isq = row >= TG * 8;
    int rr = isq ? row - TG * 8 : row;
    int tok = rr >> 3, hh = rr & 7;
    u16* dst = (isq ? W.QC : W.KC) + (size_t)tok * 1536 + hh * 192 + half * 96;
    const float* g = (isq ? P.in[I_MQG] : P.in[I_MKG]) + layer * 192 + half * 96;
    float v[96];
    const u16* s0 = dst;
    const u16* s1 = (half == 1 && !isq) ? (W.Y + (size_t)tok * LDY + O_KPE) : dst + 32;
#pragma unroll
    for (int c = 0; c < 4; ++c) {
      u32x4 u = *(const u32x4*)(s0 + 8 * c);
      v[8 * c] = bflo(u.x); v[8 * c + 1] = bfhi(u.x); v[8 * c + 2] = bflo(u.y); v[8 * c + 3] = bfhi(u.y);
      v[8 * c + 4] = bflo(u.z); v[8 * c + 5] = bfhi(u.z); v[8 * c + 6] = bflo(u.w); v[8 * c + 7] = bfhi(u.w);
    }
#pragma unroll
    for (int c = 0; c < 8; ++c) {
      u32x4 u = *(const u32x4*)(s1 + 8 * c);
      v[32 + 8 * c] = bflo(u.x); v[32 + 8 * c + 1] = bfhi(u.x); v[32 + 8 * c + 2] = bflo(u.y); v[32 + 8 * c + 3] = bfhi(u.y);
      v[32 + 8 * c + 4] = bflo(u.z); v[32 + 8 * c + 5] = bfhi(u.z); v[32 + 8 * c + 6] = bflo(u.w); v[32 + 8 * c + 7] = bfhi(u.w);
    }
    float ss = 0.f;
#pragma unroll
    for (int i = 0; i < 96; ++i) ss += v[i] * v[i];
    ss += shx(ss, 1);
    float sc = rsqrtf(ss * (1.f / 192.f) + EPSV);
#pragma unroll
    for (int i = 0; i < 96; i += 4) {
      f32x4 g4 = *(const f32x4*)(g + i);
      v[i] *= sc * g4.x; v[i + 1] *= sc * g4.y; v[i + 2] *= sc * g4.z; v[i + 3] *= sc * g4.w;
    }
    if (half == 1) {
      float pos = (float)(tok & 4095);
#pragma unroll
      for (int i = 0; i < 32; ++i) {
        float c, s; rot_cs(pos, W.rope[8 + i], c, s);
        float x1 = v[32 + i], x2 = v[64 + i];
        v[32 + i] = x1 * c - x2 * s; v[64 + i] = x2 * c + x1 * s;
      }
    }
    const float qs = isq ? 0.07216878364870322f * LOG2E : 1.f;
#pragma unroll
    for (int c = 0; c < 12; ++c) {
      u32x4 o;
      o.x = pack2(v[8 * c] * qs, v[8 * c + 1] * qs); o.y = pack2(v[8 * c + 2] * qs, v[8 * c + 3] * qs);
      o.z = pack2(v[8 * c + 4] * qs, v[8 * c + 5] * qs); o.w = pack2(v[8 * c + 6] * qs, v[8 * c + 7] * qs);
      *(u32x4*)(dst + 8 * c) = o;
    }
  }
}

DI void p_convert(const float* pin, u16* pb, int n8) {
  for (int i = blockIdx.x * NTHR + get_tid(); i < n8; i += gridDim.x * NTHR) {
    const f32x4 a = *(const f32x4*)(pin + (size_t)i * 8), b = *(const f32x4*)(pin + (size_t)i * 8 + 4);
    u32x4 o; o.x = pack2(a.x, a.y); o.y = pack2(a.z, a.w); o.z = pack2(b.x, b.y); o.w = pack2(b.z, b.w);
    *(u32x4*)(pb + (size_t)i * 8) = o;
  }
}
template <int DKL, int DQK, int MODE>
DI void attn_core(const u16* Qw, int ldq, const u16* Kg, int ldk, const u16* VTg, int kcol_off, int qpos0, float dl,
                  f32x16 (&o)[4], float& l_out, unsigned char* smem, int kt0 = 0, int nkt = 64, bool zero_o = true, const bf16x8* qpre = nullptr) {
  constexpr int KST = DKL + 8;
  constexpr int KCH = DKL / 8;
  constexpr int NKL = DKL / 64;
  constexpr int NQ = DQK / 16;
  constexpr int STG = 64 * KST + 128 * 72;
  u16* S0 = (u16*)smem;
  const int tid = get_tid(), lane = tid & 63, r = lane & 31, h = lane >> 5;
  bf16x8 qf[NQ];
#pragma unroll
  for (int ks = 0; ks < NQ; ++ks) qf[ks] = qpre ? qpre[ks] : *(const bf16x8*)(Qw + (size_t)r * ldq + 16 * ks + 8 * h);
  if (zero_o) {
#pragma unroll
    for (int dt = 0; dt < 4; ++dt)
#pragma unroll
      for (int e = 0; e < 16; ++e) o[dt][e] = 0.f;
  }
  float m_run = -1e30f, l_run = 0.f;
  u32x4 rk[NKL], rv[2];
  u32 koff[NKL]; int klds[NKL];
#pragma unroll
  for (int i = 0; i < NKL; ++i) { int c = tid + NTHR * i; int row = c / KCH, kc = c % KCH; koff[i] = (u32)(row * ldk + 8 * kc) * 2u; klds[i] = row * KST + 8 * kc; }
  const u32 voff = (u32)((tid >> 3) * 4096 + 8 * (tid & 7)) * 2u;
  const int vlds = 64 * KST + (tid >> 3) * 72 + 8 * (tid & 7);
  auto gload = [&](int k0) __attribute__((always_inline)) {
    const char* kb = (const char*)Kg + (size_t)k0 * ldk * 2;
#pragma unroll
    for (int i = 0; i < NKL; ++i) rk[i] = *(const u32x4*)(kb + koff[i]);
    const char* vb = (const char*)VTg + (size_t)k0 * 2;
#pragma unroll
    for (int i = 0; i < 2; ++i) rv[i] = *(const u32x4*)(vb + (size_t)i * 64 * 4096 * 2 + voff);
  };
  auto lstore = [&](int b) __attribute__((always_inline)) {
    u16* St = S0 + b * STG;
#pragma unroll
    for (int i = 0; i < NKL; ++i) *(u32x4*)(St + klds[i]) = rk[i];
#pragma unroll
    for (int i = 0; i < 2; ++i) *(u32x4*)(St + vlds + i * 64 * 72) = rv[i];
  };
  gload(kt0 * 64);
  __syncthreads();
  lstore(0);
  gload((kt0 + 1) * 64);
  __syncthreads();
  const float qpos = (float)(qpos0 + r);
#pragma unroll 1
  for (int kt = 0; kt < nkt; ++kt) {
    const u16* Ks = S0 + (kt & 1) * STG;
    const u16* Vs = Ks + 64 * KST;
    f32x16 st[2];
#pragma unroll
    for (int t2 = 0; t2 < 2; ++t2)
#pragma unroll
      for (int e = 0; e < 16; ++e) st[t2][e] = (MODE == 1) ? -dl : 0.f;
    {
      constexpr int BPT = NQ / 4;
      constexpr int NBAT = 2 * BPT;
      bf16x8 kf[2][4];
#pragma unroll
      for (int i = 0; i < 4; ++i) kf[0][i] = *(const bf16x8*)(Ks + r * KST + kcol_off + 16 * i + 8 * h);
#pragma unroll
      for (int g = 0; g < NBAT; ++g) {
        if (g + 1 < NBAT) {
          const int t2n = (g + 1) / BPT, bn = (g + 1) % BPT;
#pragma unroll
          for (int i = 0; i < 4; ++i) kf[(g + 1) & 1][i] = *(const bf16x8*)(Ks + (32 * t2n + r) * KST + kcol_off + 16 * (4 * bn + i) + 8 * h);
        }
        __builtin_amdgcn_sched_barrier(0);
        const int t2 = g / BPT, b = g % BPT;
#pragma unroll
        for (int i = 0; i < 4; ++i) st[t2] = MFMA32(kf[g & 1][i], qf[4 * b + i], st[t2]);
        __builtin_amdgcn_sched_barrier(0);
      }
    }
    bf16x8 vf[2][4];
#pragma unroll
    for (int dt = 0; dt < 4; ++dt) vf[0][dt] = *(const bf16x8*)(Vs + (32 * dt + r) * 72 + 8 * h);
    if (MODE == 2) {
      const float kb = (float)((kt0 + kt) * 64 + 4 * h);
#pragma unroll
      for (int t2 = 0; t2 < 2; ++t2)
#pragma unroll
        for (int e = 0; e < 16; ++e) {
          float kp = kb + (float)(32 * t2 + (e & 3) + 8 * (e >> 2));
          st[t2][e] *= __builtin_amdgcn_exp2f(dl * fabsf(qpos - kp));
        }
    } else if (MODE == 1) {
      float ls = 0.f;
#pragma unroll
      for (int t2 = 0; t2 < 2; ++t2)
#pragma unroll
        for (int e = 0; e < 16; ++e) { float p = __builtin_amdgcn_exp2f(st[t2][e]); st[t2][e] = p; ls += p; }
      l_run += ls;
    } else {
      float mx = st[0][0];
#pragma unroll
      for (int t2 = 0; t2 < 2; ++t2)
#pragma unroll
        for (int e = 0; e < 16; ++e) mx = fmaxf(mx, st[t2][e]);
      mx = fmaxf(mx, shx(mx, 32));
      float mnew = fmaxf(m_run, mx);
      float alpha = __builtin_amdgcn_exp2f(m_run - mnew);
      const bool changed = mnew > m_run;
      m_run = mnew;
      float ls = 0.f;
#pragma unroll
      for (int t2 = 0; t2 < 2; ++t2)
#pragma unroll
        for (int e = 0; e < 16; ++e) { float p = __builtin_amdgcn_exp2f(st[t2][e] - mnew); st[t2][e] = p; ls += p; }
      l_run = l_run * alpha + ls;
      if (__any(changed)) {
#pragma unroll
        for (int dt = 0; dt < 4; ++dt)
#pragma unroll
          for (int e = 0; e < 16; ++e) o[dt][e] *= alpha;
      }
    }
#pragma unroll
    for (int c = 0; c < 4; ++c) {
      const int t2 = c >> 1, s2 = c & 1;
      if (c + 1 < 4) {
#pragma unroll
        for (int dt = 0; dt < 4; ++dt) vf[(c + 1) & 1][dt] = *(const bf16x8*)(Vs + (32 * dt + r) * 72 + 16 * (c + 1) + 8 * h);
      }
      u32x4 pk;
      pk.x = pack2(st[t2][8 * s2], st[t2][8 * s2 + 1]); pk.y = pack2(st[t2][8 * s2 + 2], st[t2][8 * s2 + 3]);
      pk.z = pack2(st[t2][8 * s2 + 4], st[t2][8 * s2 + 5]); pk.w = pack2(st[t2][8 * s2 + 6], st[t2][8 * s2 + 7]);
      bf16x8 pf = __builtin_bit_cast(bf16x8, pk);
      __builtin_amdgcn_sched_barrier(0);
#pragma unroll
      for (int dt = 0; dt < 4; ++dt) o[dt] = MFMA32(vf[c & 1][dt], pf, o[dt]);
      __builtin_amdgcn_sched_barrier(0);
    }
    if (kt + 1 < nkt) lstore((kt + 1) & 1);
    if (kt + 2 < nkt) gload((kt0 + kt + 2) * 64);
    __syncthreads();
  }
  l_out = l_run + shx(l_run, 32);
}

DI void store_o(const f32x16 (&o)[4], u16* rowp, int h) {
#pragma unroll
  for (int dt = 0; dt < 4; ++dt)
#pragma unroll
    for (int g = 0; g < 4; ++g) {
      u32x2 v; v.x = pack2(o[dt][4 * g], o[dt][4 * g + 1]); v.y = pack2(o[dt][4 * g + 2], o[dt][4 * g + 3]);
      *(u32x2*)(rowp + 32 * dt + 8 * g + 4 * h) = v;
    }
}


DI void ret_kv_item(const WsPtrs& W, int item, unsigned char* smem) {
  const int tid = get_tid(), lane = tid & 63, w = tid >> 6, r = lane & 31, h = lane >> 5;
  const int bh = item >> 4, qb = item & 15, bl = bh >> 3, hh = bh & 7;
  const float dl = log2f(1.f - exp2f(-5.f - (float)hh));
  u16* KTf = (u16*)smem;
  u16* KTb = KTf + 64 * 264;
  u16* VT = KTb + 64 * 264;
  const size_t tok0 = (size_t)bl * 4096 + qb * 256;
  __syncthreads();
  {
    const int j = tid >> 1, half = tid & 1;
    const u16* kp = W.Y + (tok0 + j) * LDY + O_DK + hh * 64 + half * 32;
    const float wf = __builtin_amdgcn_exp2f(dl * (float)(255 - j)), wb = __builtin_amdgcn_exp2f(dl * (float)j);
    const int jp = vperm(j);
#pragma unroll
    for (int c = 0; c < 4; ++c) {
      const u32x4 u = *(const u32x4*)(kp + 8 * c);
      const float kv[8] = {bflo(u.x), bfhi(u.x), bflo(u.y), bfhi(u.y), bflo(u.z), bfhi(u.z), bflo(u.w), bfhi(u.w)};
#pragma unroll
      for (int i = 0; i < 8; ++i) {
        const int dk = half * 32 + 8 * c + i;
        KTf[dk * 264 + jp] = (u16)pack2(kv[i] * wf, 0.f);
        KTb[dk * 264 + jp] = (u16)pack2(kv[i] * wb, 0.f);
      }
    }
    const u16* vp = W.DVT + (size_t)bh * 128 * 4096 + qb * 256;
#pragma unroll
    for (int i = 0; i < 8; ++i) {
      const int c = tid + 512 * i, row = c >> 5, kc = c & 31;
      *(u32x4*)(VT + row * 264 + 8 * kc) = *(const u32x4*)(vp + (size_t)row * 4096 + 8 * kc);
    }
  }
  __syncthreads();
  const int tk = w >> 2, tv = w & 3;
  f32x16 af, ab;
#pragma unroll
  for (int e = 0; e < 16; ++e) { af[e] = 0.f; ab[e] = 0.f; }
#pragma unroll
  for (int ks = 0; ks < 16; ++ks) {
    const bf16x8 vfr = *(const bf16x8*)(VT + (32 * tv + r) * 264 + 16 * ks + 8 * h);
    const bf16x8 kff = *(const bf16x8*)(KTf + (32 * tk + r) * 264 + 16 * ks + 8 * h);
    const bf16x8 kfb = *(const bf16x8*)(KTb + (32 * tk + r) * 264 + 16 * ks + 8 * h);
    af = MFMA32(kff, vfr, af);
    ab = MFMA32(kfb, vfr, ab);
  }
  float* dst = W.KVS + ((size_t)((bh * 16 + qb) * 2)) * 8192 + (32 * tv + r) * 64 + 32 * tk + 4 * h;
#pragma unroll
  for (int g = 0; g < 4; ++g) {
    *(f32x4*)(dst + 8 * g) = f32x4{af[4 * g], af[4 * g + 1], af[4 * g + 2], af[4 * g + 3]};
    *(f32x4*)(dst + 8192 + 8 * g) = f32x4{ab[4 * g], ab[4 * g + 1], ab[4 * g + 2], ab[4 * g + 3]};
  }
}
DI void ret_state_scan(const WsPtrs& W, int G) {
  const int nthr = G * 8 * 2048;
  for (int i = blockIdx.x * NTHR + get_tid(); i < nthr; i += gridDim.x * NTHR) {
    const int bh = i >> 11, e4 = (i & 2047) * 4, hh = bh & 7;
    const float g256 = exp2f(256.f * log2f(1.f - exp2f(-5.f - (float)hh)));
    const float* kv = W.KVS + (size_t)bh * 16 * 2 * 8192 + e4;
    u16* pf = W.PF + (size_t)bh * 16 * 2 * 8192 + e4;
    f32x4 st = f32x4{0.f, 0.f, 0.f, 0.f};
#pragma unroll 4
    for (int qb = 0; qb < 16; ++qb) {
      u32x2 o2; o2.x = pack2(st.x, st.y); o2.y = pack2(st.z, st.w);
      *(u32x2*)(pf + (size_t)(qb * 2) * 8192) = o2;
      const f32x4 a = *(const f32x4*)(kv + (size_t)(qb * 2) * 8192);
      st.x = st.x * g256 + a.x; st.y = st.y * g256 + a.y; st.z = st.z * g256 + a.z; st.w = st.w * g256 + a.w;
    }
    st = f32x4{0.f, 0.f, 0.f, 0.f};
#pragma unroll 4
    for (int qb = 15; qb >= 0; --qb) {
      u32x2 o2; o2.x = pack2(st.x, st.y); o2.y = pack2(st.z, st.w);
      *(u32x2*)(pf + (size_t)(qb * 2 + 1) * 8192) = o2;
      const f32x4 a = *(const f32x4*)(kv + (size_t)(qb * 2 + 1) * 8192);
      st.x = st.x * g256 + a.x; st.y = st.y * g256 + a.y; st.z = st.z * g256 + a.z; st.w = st.w * g256 + a.w;
    }
  }
}

DI void mla_attn_item(const WsPtrs& W, const float* pgq, const float* pgk, int item, unsigned char* smem) {
  const int w = get_tid() >> 6, lane = get_tid() & 63, r = lane & 31, h = lane >> 5;
  int bh = item >> 4, qb = item & 15, bl = bh >> 3, hh = bh & 7;
  int q0 = qb * 256 + 32 * w;
  size_t tokb = (size_t)bl * 4096;
  f32x16 o[4]; float l;
  float gq = 0.f, gk = 0.f;
  for (int i = lane; i < 192; i += 64) { gq = fmaxf(gq, fabsf(pgq[i])); gk = fmaxf(gk, fabsf(pgk[i])); }
#pragma unroll
  for (int of = 32; of > 0; of >>= 1) { gq = fmaxf(gq, shx(gq, of)); gk = fmaxf(gk, shx(gk, of)); }
  const float M = 19.99f * gq * gk * 1.02f + 1.f;
  bf16x8 qn[12];
  {
    const u16* Qr = W.QC + (tokb + q0 + r) * 1536 + hh * 192 + 8 * h;
    u32x4 raw[12];
#pragma unroll
    for (int ks = 0; ks < 12; ++ks) raw[ks] = *(const u32x4*)(Qr + 16 * ks);
    float ss = 0.f;
#pragma unroll
    for (int ks = 0; ks < 12; ++ks) {
      float a;
      a = bflo(raw[ks].x); ss += a * a; a = bfhi(raw[ks].x); ss += a * a; a = bflo(raw[ks].y); ss += a * a; a = bfhi(raw[ks].y); ss += a * a;
      a = bflo(raw[ks].z); ss += a * a; a = bfhi(raw[ks].z); ss += a * a; a = bflo(raw[ks].w); ss += a * a; a = bfhi(raw[ks].w); ss += a * a;
    }
    ss += shx(ss, 32);
    const float sc = rsqrtf(ss * (1.f / 192.f) + EPSV) * (0.07216878364870322f * LOG2E);
    const float pos = (float)(q0 + r);
    auto scaled = [&](int ks, float (&v)[8]) __attribute__((always_inline)) {
      const f32x4 g0 = *(const f32x4*)(pgq + 16 * ks + 8 * h), g1 = *(const f32x4*)(pgq + 16 * ks + 8 * h + 4);
      v[0] = bflo(raw[ks].x) * sc * g0.x; v[1] = bfhi(raw[ks].x) * sc * g0.y; v[2] = bflo(raw[ks].y) * sc * g0.z; v[3] = bfhi(raw[ks].y) * sc * g0.w;
      v[4] = bflo(raw[ks].z) * sc * g1.x; v[5] = bfhi(raw[ks].z) * sc * g1.y; v[6] = bflo(raw[ks].w) * sc * g1.z; v[7] = bfhi(raw[ks].w) * sc * g1.w;
    };
    auto packed = [&](const float (&v)[8]) __attribute__((always_inline)) {
      u32x4 p; p.x = pack2(v[0], v[1]); p.y = pack2(v[2], v[3]); p.z = pack2(v[4], v[5]); p.w = pack2(v[6], v[7]);
      return __builtin_bit_cast(bf16x8, p);
    };
#pragma unroll
    for (int ks = 0; ks < 8; ++ks) { float v[8]; scaled(ks, v); qn[ks] = packed(v); }
#pragma unroll
    for (int ks = 8; ks < 10; ++ks) {
      float x1[8], x2[8]; scaled(ks, x1); scaled(ks + 2, x2);
#pragma unroll
      for (int i = 0; i < 8; ++i) {
        float c, sn; rot_cs(pos, W.rope[8 + 16 * (ks - 8) + 8 * h + i], c, sn);
        const float a = x1[i] * c - x2[i] * sn, b = x2[i] * c + x1[i] * sn;
        x1[i] = a; x2[i] = b;
      }
      qn[ks] = packed(x1); qn[ks + 2] = packed(x2);
    }
  }
  if (M <= 56.f)
    attn_core<192, 192, 1>(W.QC + (tokb + q0) * 1536 + hh * 192, 1536, W.KC + tokb * 1536 + hh * 192, 1536,
                           W.CVT + (size_t)bh * 128 * 4096, 0, q0, M, o, l, smem, 0, 64, true, qn);
  else
    attn_core<192, 192, 0>(W.QC + (tokb + q0) * 1536 + hh * 192, 1536, W.KC + tokb * 1536 + hh * 192, 1536,
                           W.CVT + (size_t)bh * 128 * 4096, 0, q0, 0.f, o, l, smem, 0, 64, true, qn);
  float inv = 1.f / l;
#pragma unroll
  for (int dt = 0; dt < 4; ++dt)
#pragma unroll
    for (int e = 0; e < 16; ++e) o[dt][e] *= inv;
  store_o(o, W.YMIX + (tokb + q0 + r) * 4096 + 2048 + hh * 128, h);
}

DI void ret_attn_item(const Params& P, const WsPtrs& W, int layer, int item, unsigned char* smem) {
  const int w = get_tid() >> 6, lane = get_tid() & 63;
  int r = lane & 31, h = lane >> 5;
  int bh = item >> 4, qb = item & 15, bl = bh >> 3, hh = bh & 7;
  int q0 = qb * 256 + 32 * w;
  size_t tokb = (size_t)bl * 4096;
  float dl = log2f(1.f - exp2f(-5.f - (float)hh));
  f32x16 o[4]; float l;
  {
    const u16* Qw = W.Y + (tokb + q0) * LDY + O_DQ + hh * 64;
    bf16x8 qf[4];
#pragma unroll
    for (int ks = 0; ks < 4; ++ks) qf[ks] = *(const bf16x8*)(Qw + (size_t)r * LDY + 16 * ks + 8 * h);
    const float nrel = (float)(q0 - qb * 256 + r);
#pragma unroll
    for (int dir = 0; dir < 2; ++dir) {
      const u16* st = W.PF + ((size_t)((bh * 16 + qb) * 2 + dir)) * 8192;
      const float sc = __builtin_amdgcn_exp2f(dl * (dir == 0 ? nrel + 1.f : 256.f - nrel));
#pragma unroll
      for (int dt = 0; dt < 4; ++dt) {
        f32x16 tq;
#pragma unroll
        for (int e = 0; e < 16; ++e) tq[e] = 0.f;
#pragma unroll
        for (int ks = 0; ks < 4; ++ks) {
          bf16x8 af = *(const bf16x8*)(st + (32 * dt + r) * 64 + 16 * ks + 8 * h);
          tq = MFMA32(af, qf[ks], tq);
        }
#pragma unroll
        for (int e = 0; e < 16; ++e) o[dt][e] = (dir == 0 ? 0.f : o[dt][e]) + sc * tq[e];
      }
    }
  }
  attn_core<64, 64, 2>(W.Y + (tokb + q0) * LDY + O_DQ + hh * 64, LDY, W.Y + tokb * LDY + O_DK + hh * 64, LDY,
                          W.DVT + (size_t)bh * 128 * 4096, 0, q0, dl, o, l, smem, 4 * qb, 4, false);
  {
    const int it2 = launder_s(item), t2 = get_tid();
    bh = it2 >> 4; qb = it2 & 15; bl = bh >> 3; hh = bh & 7; q0 = qb * 256 + 32 * (t2 >> 6); tokb = (size_t)bl * 4096;
    r = (t2 & 63) & 31; h = (t2 & 63) >> 5;
  }
  float sm = 0.f;
#pragma unroll
  for (int dt = 0; dt < 4; ++dt)
#pragma unroll
    for (int e = 0; e < 16; ++e) sm += o[dt][e];
  sm += shx(sm, 32);
  float mean = sm * (1.f / 128.f), vs = 0.f;
#pragma unroll
  for (int dt = 0; dt < 4; ++dt)
#pragma unroll
    for (int e = 0; e < 16; ++e) { float d = o[dt][e] - mean; o[dt][e] = d; vs += d * d; }
  vs += shx(vs, 32);
  float sc = rsqrtf(vs * (1.f / 128.f) + EPSV);
  const float* gn = P.in[I_GNG] + layer * 128;
  const u16* gg = W.Y + (tokb + q0 + r) * LDY + O_DG + hh * 128;
#pragma unroll
  for (int dt = 0; dt < 4; ++dt)
#pragma unroll
    for (int g = 0; g < 4; ++g) {
      int c = 32 * dt + 8 * g + 4 * h;
      f32x4 g4 = *(const f32x4*)(gn + c);
      u32x2 sg = *(const u32x2*)(gg + c);
      float s0 = bflo(sg.x), s1 = bfhi(sg.x), s2 = bflo(sg.y), s3 = bfhi(sg.y);
      o[dt][4 * g] *= sc * g4.x * s0 * sigmoidf_(s0); o[dt][4 * g + 1] *= sc * g4.y * s1 * sigmoidf_(s1);
      o[dt][4 * g + 2] *= sc * g4.z * s2 * sigmoidf_(s2); o[dt][4 * g + 3] *= sc * g4.w * s3 * sigmoidf_(s3);
    }
  store_o(o, W.YMIX + (tokb + q0 + r) * 4096 + 3072 + hh * 128, h);
}

DI void diff_attn_item(const Params& P, const WsPtrs& W, int layer, int item, unsigned char* smem) {
  const int w = get_tid() >> 6, lane = get_tid() & 63, r = lane & 31, h = lane >> 5;
  int bh = item >> 5, qb = item & 31, bl = bh >> 3, hh = bh & 7;
  int sub = w >> 2;
  int q0 = qb * 128 + 32 * (w & 3);
  size_t tokb = (size_t)bl * 4096;
  f32x16 o[4]; float l;
  float gq = fabsf(P.in[I_DQG][layer * 64 + lane]), gk = fabsf(P.in[I_DKG][layer * 64 + lane]);
#pragma unroll
  for (int of = 32; of > 0; of >>= 1) { gq = fmaxf(gq, shx(gq, of)); gk = fmaxf(gk, shx(gk, of)); }
  const float M = 11.5416f * gq * gk * 1.02f + 1.f;
  if (M <= 56.f)
    attn_core<128, 64, 1>(W.Y + (tokb + q0) * LDY + O_BQ + hh * 128 + sub * 64, LDY, W.Y + tokb * LDY + O_BK + hh * 128, LDY,
                          W.BVT + (size_t)bh * 128 * 4096, sub * 64, q0, M, o, l, smem);
  else
    attn_core<128, 64, 0>(W.Y + (tokb + q0) * LDY + O_BQ + hh * 128 + sub * 64, LDY, W.Y + tokb * LDY + O_BK + hh * 128, LDY,
                          W.BVT + (size_t)bh * 128 * 4096, sub * 64, q0, 0.f, o, l, smem);
  float inv = 1.f / l;
  float* ex = (float*)smem;
  __syncthreads();
  if (sub == 1) {
#pragma unroll
    for (int dt = 0; dt < 4; ++dt)
#pragma unroll
      for (int e = 0; e < 16; ++e) ex[((w & 3) * 64 + dt * 16 + e) * 64 + lane] = o[dt][e] * inv;
  }
  __syncthreads();
  if (sub == 0) {
    const float* lp = P.in[I_DLAM] + layer * 256;
    float s1 = 0.f, s2 = 0.f;
    for (int i = 0; i < 64; ++i) { s1 += lp[i] * lp[64 + i]; s2 += lp[128 + i] * lp[192 + i]; }
    const float lam_init = (launder_s(layer) == 0) ? 0.2f : (0.8f - 0.6f * 0.7408182206817179f);
    const float lam = __expf(s1) - __expf(s2) + lam_init;
    float ss = 0.f;
#pragma unroll
    for (int dt = 0; dt < 4; ++dt)
#pragma unroll
      for (int e = 0; e < 16; ++e) {
        float v = o[dt][e] * inv - lam * ex[((w & 3) * 64 + dt * 16 + e) * 64 + lane];
        o[dt][e] = v; ss += v * v;
      }
    ss += shx(ss, 32);
    float sc = rsqrtf(ss * (1.f / 128.f) + EPSV) * (1.f - lam_init);
    const float* sg = P.in[I_DSUBG] + layer * 128;
#pragma unroll
    for (int dt = 0; dt < 4; ++dt)
#pragma unroll
      for (int g = 0; g < 4; ++g) {
        f32x4 g4 = *(const f32x4*)(sg + 32 * dt + 8 * g + 4 * h);
        o[dt][4 * g] *= sc * g4.x; o[dt][4 * g + 1] *= sc * g4.y; o[dt][4 * g + 2] *= sc * g4.z; o[dt][4 * g + 3] *= sc * g4.w;
      }
    store_o(o, W.YMIX + (tokb + q0 + r) * 4096 + 1024 + hh * 128, h);
  }
}

DI void lru_item(const Params& P, const WsPtrs& W, int layer, int item, unsigned char* smem) {
  const int tid = get_tid(), lane = tid & 63, w = tid >> 6, r = lane & 31, h = lane >> 5;
  const int bl = item >> 4, nb = item & 15, c0 = nb * 64;
  u16* XCb = (u16*)smem;
  float* XU = (float*)(smem + 18432);
  float* AA = (float*)(smem + 18432 + 34816);
  u16* WaT = (u16*)(smem + 18432 + 2 * 34816);
  u16* WxT = WaT + 64 * 72;
  float* CW = (float*)(smem + 18432 + 2 * 34816 + 2 * 9216);
  float* SEG = CW + 320;
  const size_t tokb = (size_t)bl * 4096;
  const u16* ax = W.Y + tokb * LDY + O_AX + c0;
  const u16* gag = W.Y + tokb * LDY + O_AG + c0;
  const int tt = tid >> 2, cg4 = tid & 3, cb16 = 16 * cg4;
  const int tm = w >> 1, tn = w & 1;
  __syncthreads();
  if (tid < 64) {
#pragma unroll
    for (int j = 0; j < 4; ++j) CW[j * 64 + tid] = P.in[I_CONVW][layer * 4096 + j * 1024 + c0 + tid];
    CW[4 * 64 + tid] = P.in[I_CONVB][layer * 1024 + c0 + tid];
  }
  for (int d = 0; d < 2; ++d) {
    __syncthreads();
    {
      const float* wa = P.in[I_WA] + ((size_t)((layer * 2 + d) * 16 + nb)) * 4096;
      const float* wx = P.in[I_WX] + ((size_t)((layer * 2 + d) * 16 + nb)) * 4096;
      int ci = tid >> 2;
      if (tid < 256)
#pragma unroll
      for (int q = 0; q < 4; ++q) {
        f32x4 a4 = *(const f32x4*)(wa + ci * 64 + cb16 + 4 * q);
        f32x4 x4 = *(const f32x4*)(wx + ci * 64 + cb16 + 4 * q);
        int co = cb16 + 4 * q;
        WaT[(co + 0) * 72 + ci] = (u16)pack2(a4.x, 0.f); WaT[(co + 1) * 72 + ci] = (u16)pack2(a4.y, 0.f);
        WaT[(co + 2) * 72 + ci] = (u16)pack2(a4.z, 0.f); WaT[(co + 3) * 72 + ci] = (u16)pack2(a4.w, 0.f);
        WxT[(co + 0) * 72 + ci] = (u16)pack2(x4.x, 0.f); WxT[(co + 1) * 72 + ci] = (u16)pack2(x4.y, 0.f);
        WxT[(co + 2) * 72 + ci] = (u16)pack2(x4.z, 0.f); WxT[(co + 3) * 72 + ci] = (u16)pack2(x4.w, 0.f);
      }
    }
    const int cl = 32 * tn + r;
    const float ba = P.in[I_BA][(layer * 2 + d) * 1024 + c0 + cl];
    const float bx = P.in[I_BX][(layer * 2 + d) * 1024 + c0 + cl];
    const float lamv = P.in[I_LAM][(layer * 2 + d) * 1024 + c0 + cl];
    const float sp = 8.f * log1pf(expf(-lamv));
    float carry = 0.f;
    u32x4 pre[8];
    auto lru_issue = [&](int t0n) __attribute__((always_inline)) {
#pragma unroll
      for (int j = 0; j < 4; ++j) {
        int t = t0n + tt + j - 2;
        if (t >= 0 && t < 4096) {
          pre[2 * j] = *(const u32x4*)(ax + (size_t)t * LDY + cb16);
          pre[2 * j + 1] = *(const u32x4*)(ax + (size_t)t * LDY + cb16 + 8);
        } else { pre[2 * j] = u32x4{0u, 0u, 0u, 0u}; pre[2 * j + 1] = u32x4{0u, 0u, 0u, 0u}; }
      }
    };
    lru_issue((d ? 31 : 0) * 128);
    for (int ci = 0; ci < 32; ++ci) {
      const int t0 = (d ? 31 - ci : ci) * 128;
      {
        float xc[16];
#pragma unroll
        for (int q = 0; q < 4; ++q) { f32x4 b4 = *(const f32x4*)(CW + 256 + cb16 + 4 * q); xc[4 * q] = b4.x; xc[4 * q + 1] = b4.y; xc[4 * q + 2] = b4.z; xc[4 * q + 3] = b4.w; }
#pragma unroll
        for (int j = 0; j < 4; ++j) {
          {
            u32x4 u0 = pre[2 * j], u1 = pre[2 * j + 1];
            float xv[16] = {bflo(u0.x), bfhi(u0.x), bflo(u0.y), bfhi(u0.y), bflo(u0.z), bfhi(u0.z), bflo(u0.w), bfhi(u0.w),
                            bflo(u1.x), bfhi(u1.x), bflo(u1.y), bfhi(u1.y), bflo(u1.z), bfhi(u1.z), bflo(u1.w), bfhi(u1.w)};
#pragma unroll
            for (int q = 0; q < 4; ++q) {
              f32x4 w4 = *(const f32x4*)(CW + j * 64 + cb16 + 4 * q);
              xc[4 * q] += xv[4 * q] * w4.x; xc[4 * q + 1] += xv[4 * q + 1] * w4.y; xc[4 * q + 2] += xv[4 * q + 2] * w4.z; xc[4 * q + 3] += xv[4 * q + 3] * w4.w;
            }
          }
        }
#pragma unroll
        for (int q = 0; q < 4; ++q) *(f32x4*)(XU + tt * 68 + cb16 + 4 * q) = f32x4{xc[4 * q], xc[4 * q + 1], xc[4 * q + 2], xc[4 * q + 3]};
        u32x4 o0, o1;
        o0.x = pack2(xc[0], xc[1]); o0.y = pack2(xc[2], xc[3]); o0.z = pack2(xc[4], xc[5]); o0.w = pack2(xc[6], xc[7]);
        o1.x = pack2(xc[8], xc[9]); o1.y = pack2(xc[10], xc[11]); o1.z = pack2(xc[12], xc[13]); o1.w = pack2(xc[14], xc[15]);
        *(u32x4*)(XCb + tt * 72 + cb16) = o0; *(u32x4*)(XCb + tt * 72 + cb16 + 8) = o1;
      }
      if (ci + 1 < 32) lru_issue((d ? 30 - ci : ci + 1) * 128);
      u32x4 g0, g1; f32x4 hfp[4];
      if (d == 1) {
        g0 = *(const u32x4*)(gag + (size_t)(t0 + tt) * LDY + cb16);
        g1 = *(const u32x4*)(gag + (size_t)(t0 + tt) * LDY + cb16 + 8);
        const float* hfr = W.HF + (tokb + t0 + tt) * 1024 + c0 + cb16;
#pragma unroll
        for (int q = 0; q < 4; ++q) hfp[q] = *(const f32x4*)(hfr + 4 * q);
      }
      __syncthreads();
      {
        f32x16 ra, rx;
#pragma unroll
        for (int e = 0; e < 16; ++e) { ra[e] = 0.f; rx[e] = 0.f; }
#pragma unroll
        for (int ks = 0; ks < 4; ++ks) {
          bf16x8 xa = *(const bf16x8*)(XCb + (32 * tm + r) * 72 + 16 * ks + 8 * h);
          bf16x8 wa = *(const bf16x8*)(WaT + (32 * tn + r) * 72 + 16 * ks + 8 * h);
          bf16x8 wx = *(const bf16x8*)(WxT + (32 * tn + r) * 72 + 16 * ks + 8 * h);
          ra = MFMA32(xa, wa, ra);
          rx = MFMA32(xa, wx, rx);
        }
#pragma unroll
        for (int e = 0; e < 16; ++e) {
          int tk = 32 * tm + crow(e, h);
          float rg = __builtin_amdgcn_rcpf(1.f + __builtin_amdgcn_exp2f(-LOG2E * (ra[e] + ba)));
          float ig = __builtin_amdgcn_rcpf(1.f + __builtin_amdgcn_exp2f(-LOG2E * (rx[e] + bx)));
          float a = __builtin_amdgcn_exp2f(-LOG2E * rg * sp);
          float xcv = XU[tk * 68 + cl];
          float u = __builtin_amdgcn_sqrtf(fmaxf(1.f - a * a, 0.f)) * ig * xcv;
          AA[tk * 68 + cl] = a; XU[tk * 68 + cl] = u;
        }
      }
      __syncthreads();
      {
        float hc = 0.f, pc = 1.f;
#pragma unroll
        for (int i = 0; i < 16; ++i) {
          const int io = 16 * w + i, tk = d ? 127 - io : io;
          const float a = AA[tk * 68 + lane], u = XU[tk * 68 + lane];
          hc = a * hc + u; pc = a * pc;
          XU[tk * 68 + lane] = hc; AA[tk * 68 + lane] = pc;
        }
        SEG[w * 64 + lane] = hc; SEG[512 + w * 64 + lane] = pc;
      }
      __syncthreads();
      {
        float cin = carry, cmine = carry;
#pragma unroll
        for (int ww = 0; ww < 8; ++ww) {
          if (ww == w) cmine = cin;
          cin = SEG[512 + ww * 64 + lane] * cin + SEG[ww * 64 + lane];
        }
        carry = cin;
#pragma unroll
        for (int i = 0; i < 16; ++i) {
          const int io = 16 * w + i, tk = d ? 127 - io : io;
          XU[tk * 68 + lane] += AA[tk * 68 + lane] * cmine;
        }
      }
      __syncthreads();
      {
        const size_t trow = tokb + t0 + tt;
        float hv[16];
#pragma unroll
        for (int q = 0; q < 4; ++q) { f32x4 v = *(const f32x4*)(XU + tt * 68 + cb16 + 4 * q); hv[4 * q] = v.x; hv[4 * q + 1] = v.y; hv[4 * q + 2] = v.z; hv[4 * q + 3] = v.w; }
        float* hf = W.HF + trow * 1024 + c0 + cb16;
        if (d == 0) {
#pragma unroll
          for (int q = 0; q < 4; ++q) *(f32x4*)(hf + 4 * q) = f32x4{hv[4 * q], hv[4 * q + 1], hv[4 * q + 2], hv[4 * q + 3]};
        } else {
          float gv[16] = {bflo(g0.x), bfhi(g0.x), bflo(g0.y), bfhi(g0.y), bflo(g0.z), bfhi(g0.z), bflo(g0.w), bfhi(g0.w),
                          bflo(g1.x), bfhi(g1.x), bflo(g1.y), bfhi(g1.y), bflo(g1.z), bfhi(g1.z), bflo(g1.w), bfhi(g1.w)};
#pragma unroll
          for (int q = 0; q < 16; ++q) gv[q] = gelu_tanh(gv[q]);
#pragma unroll
          for (int q = 0; q < 4; ++q) {
            f32x4 f = hfp[q];
            hv[4 * q] = (hv[4 * q] + f.x) * gv[4 * q]; hv[4 * q + 1] = (hv[4 * q + 1] + f.y) * gv[4 * q + 1];
            hv[4 * q + 2] = (hv[4 * q + 2] + f.z) * gv[4 * q + 2]; hv[4 * q + 3] = (hv[4 * q + 3] + f.w) * gv[4 * q + 3];
          }
          u32x4 o0, o1;
          o0.x = pack2(hv[0], hv[1]); o0.y = pack2(hv[2], hv[3]); o0.z = pack2(hv[4], hv[5]); o0.w = pack2(hv[6], hv[7]);
          o1.x = pack2(hv[8], hv[9]); o1.y = pack2(hv[10], hv[11]); o1.z = pack2(hv[12], hv[13]); o1.w = pack2(hv[14], hv[15]);
          u16* yo = W.YMIX + trow * 4096 + c0 + cb16;
          *(u32x4*)yo = o0; *(u32x4*)(yo + 8) = o1;
        }
      }
      __syncthreads();
    }
  }
}


typedef float f32x4v __attribute__((ext_vector_type(4)));
constexpr int G8_BK = 64, G8_HALF = 128, G8_HT = G8_HALF * G8_BK;
DI int g8_lds_byte(int r, int c) {
  int st = (r >> 4) * 2 + (c >> 5), rr = r & 15, cc = c & 31, ob = rr * 64 + cc * 2;
  return st * 1024 + (ob ^ (((ob >> 9) & 1) << 5));
}
DI void g8_stage_rc(int b, int& R, int& C) {
  int st = b / 1024, sb = b % 1024, swz = sb ^ (((sb >> 9) & 1) << 5);
  R = (st >> 1) * 16 + swz / 64; C = (st & 1) * 32 + (swz % 64) / 2;
}
DI void gemm8(const u16* A, int lda, const u16* Bt, int ldb, int K, int brow, int bcol, f32x4v (&acc)[2][2][4][2], unsigned char* smem) {
  u16* shm = (u16*)smem;
#define G8_SA(b, hh) (shm + ((b) * 2 + (hh)) * G8_HT)
#define G8_SB(b, hh) (shm + (4 + (b) * 2 + (hh)) * G8_HT)
#define G8_STAGE(P, BASE, LD, br, kt) do { const char* _gb = (const char*)(BASE) + ((long)(br) * (LD) + (long)(kt) * G8_BK) * 2; \
    const bool _isA = ((const void*)(BASE) == (const void*)A); \
    __builtin_amdgcn_global_load_lds((const unsigned*)(_gb + (_isA ? offA0 : offB0)), \
        (__attribute__((address_space(3))) unsigned*)((char*)(P) + ldsb), 16, 0, 0); \
    __builtin_amdgcn_global_load_lds((const unsigned*)(_gb + (_isA ? offA1 : offB1)), \
        (__attribute__((address_space(3))) unsigned*)((char*)(P) + ldsb + 8192), 16, 0, 0); } while (0)
#define G8_LDA(dst, b, hh) for (int m = 0; m < 4; ++m) for (int k = 0; k < 2; ++k) \
    dst[m][k] = *reinterpret_cast<const bf16x8*>((char*)G8_SA(b, hh) + aLds + m * 2048 + k * 1024)
#define G8_LDB(dst, b, hh) for (int n = 0; n < 2; ++n) for (int k = 0; k < 2; ++k) \
    dst[n][k] = *reinterpret_cast<const bf16x8*>((char*)G8_SB(b, hh) + bLds + n * 2048 + k * 1024)
#define G8_MMA(ai, bj, At_, Bt_) do { __builtin_amdgcn_s_setprio(1); \
    for (int m = 0; m < 4; ++m) for (int n = 0; n < 2; ++n) for (int k = 0; k < 2; ++k) \
      acc[ai][bj][m][n] = __builtin_amdgcn_mfma_f32_16x16x32_bf16(At_[m][k], Bt_[n][k], acc[ai][bj][m][n], 0, 0, 0); \
    __builtin_amdgcn_s_setprio(0); } while (0)
#define G8_WAIT_V(n) asm volatile("s_waitcnt vmcnt(" #n ")" ::: "memory")
#define G8_WAIT_L(n) asm volatile("s_waitcnt lgkmcnt(" #n ")" ::: "memory")
#define G8_BAR __builtin_amdgcn_s_barrier()
#define G8_SCHED __builtin_amdgcn_sched_barrier(0)
  const int tidx = get_tid();
  const int wid = tidx >> 6, lane = tidx & 63, wr = wid >> 2, wc = wid & 3, fr = lane & 15, fq = lane >> 4;
#pragma unroll
  for (int a = 0; a < 2; ++a)
#pragma unroll
    for (int b = 0; b < 2; ++b)
#pragma unroll
      for (int m = 0; m < 4; ++m)
#pragma unroll
        for (int n = 0; n < 2; ++n) acc[a][b][m][n] = f32x4v{0.f, 0.f, 0.f, 0.f};
  bf16x8 At[4][2], B0[2][2], B1[2][2];
  const int nt = K / G8_BK;
  const int ldsb = tidx * 16;
  const int aLds = g8_lds_byte(wr * 64 + fr, fq * 8), bLds = g8_lds_byte(wc * 32 + fr, fq * 8);
  u32 offA0, offA1, offB0, offB1;
  { int r0, c0, r1, c1; g8_stage_rc(ldsb, r0, c0); g8_stage_rc(ldsb + 8192, r1, c1);
    offA0 = (u32)(r0 * lda + c0) * 2u; offA1 = (u32)(r1 * lda + c1) * 2u; offB0 = (u32)(r0 * ldb + c0) * 2u; offB1 = (u32)(r1 * ldb + c1) * 2u; }
  __syncthreads();
  G8_STAGE(G8_SB(0, 0), Bt, ldb, bcol, 0); G8_STAGE(G8_SA(0, 0), A, lda, brow, 0);
  G8_STAGE(G8_SB(0, 1), Bt, ldb, bcol + G8_HALF, 0); G8_STAGE(G8_SA(0, 1), A, lda, brow + G8_HALF, 0);
  if (wr == 1) G8_BAR;
  G8_WAIT_V(4); G8_BAR;
  G8_STAGE(G8_SB(1, 0), Bt, ldb, bcol, 1); G8_STAGE(G8_SA(1, 0), A, lda, brow, 1); G8_STAGE(G8_SB(1, 1), Bt, ldb, bcol + G8_HALF, 1);
  G8_WAIT_V(6); G8_BAR;
  for (int t = 0; t < nt - 2; t += 2) {
    G8_LDB(B0, 0, 0); G8_SCHED; G8_LDA(At, 0, 0); G8_STAGE(G8_SA(1, 1), A, lda, brow + G8_HALF, t + 1);
    G8_WAIT_L(8); G8_BAR; G8_WAIT_L(0); G8_MMA(0, 0, At, B0); G8_BAR; G8_SCHED;
    G8_LDB(B1, 0, 1); G8_STAGE(G8_SB(0, 0), Bt, ldb, bcol, t + 2);
    G8_BAR; G8_WAIT_L(0); G8_MMA(0, 1, At, B1); G8_BAR;
    G8_LDA(At, 0, 1); G8_STAGE(G8_SA(0, 0), A, lda, brow, t + 2);
    G8_BAR; G8_WAIT_L(0); G8_MMA(1, 0, At, B0); G8_BAR; G8_SCHED;
    G8_STAGE(G8_SB(0, 1), Bt, ldb, bcol + G8_HALF, t + 2);
    G8_WAIT_V(6); G8_BAR; G8_MMA(1, 1, At, B1); G8_BAR;
    G8_LDB(B0, 1, 0); G8_SCHED; G8_LDA(At, 1, 0); G8_STAGE(G8_SA(0, 1), A, lda, brow + G8_HALF, t + 2);
    G8_WAIT_L(8); G8_BAR; G8_WAIT_L(0); G8_MMA(0, 0, At, B0); G8_BAR; G8_SCHED;
    G8_LDB(B1, 1, 1); G8_STAGE(G8_SB(1, 0), Bt, ldb, bcol, t + 3);
    G8_BAR; G8_WAIT_L(0); G8_MMA(0, 1, At, B1); G8_BAR;
    G8_LDA(At, 1, 1); G8_STAGE(G8_SA(1, 0), A, lda, brow, t + 3);
    G8_BAR; G8_WAIT_L(0); G8_MMA(1, 0, At, B0); G8_BAR; G8_SCHED;
    G8_STAGE(G8_SB(1, 1), Bt, ldb, bcol + G8_HALF, t + 3);
    G8_WAIT_V(6); G8_BAR; G8_MMA(1, 1, At, B1); G8_BAR;
  }
  { G8_LDB(B0, 0, 0); G8_LDA(At, 0, 0); G8_STAGE(G8_SA(1, 1), A, lda, brow + G8_HALF, nt - 1);
    G8_BAR; G8_WAIT_L(0); G8_MMA(0, 0, At, B0); G8_BAR;
    G8_LDB(B1, 0, 1); G8_BAR; G8_WAIT_L(0); G8_MMA(0, 1, At, B1); G8_BAR;
    G8_LDA(At, 0, 1); G8_WAIT_V(4); G8_BAR; G8_WAIT_L(0); G8_MMA(1, 0, At, B0); G8_MMA(1, 1, At, B1); G8_BAR; }
  { G8_LDB(B0, 1, 0); G8_LDA(At, 1, 0); G8_WAIT_V(2); G8_BAR; G8_WAIT_L(0); G8_MMA(0, 0, At, B0); G8_BAR;
    G8_LDB(B1, 1, 1); G8_WAIT_V(0); G8_BAR; G8_WAIT_L(0); G8_MMA(0, 1, At, B1); G8_BAR;
    G8_LDA(At, 1, 1); G8_BAR; G8_WAIT_L(0); G8_MMA(1, 0, At, B0); G8_MMA(1, 1, At, B1); G8_BAR; }
  if (wr == 0) G8_BAR;
}


DI void resid_store8(const f32x4v (&acc)[2][2][4][2], const float* xin, float* xout, u16* xb, float* ssp, int m0, int n0, bool wr_norm = true) {
  const int tid2 = get_tid();
  const int wid = tid2 >> 6, lane = tid2 & 63, wr = wid >> 2, wc = wid & 3, fr = lane & 15, fq = lane >> 4;
#pragma unroll
  for (int bj = 0; bj < 2; ++bj)
#pragma unroll
    for (int n = 0; n < 2; ++n) {
      const int row = m0 + bj * 128 + wc * 32 + n * 16 + fr;
#pragma unroll
      for (int ai = 0; ai < 2; ++ai) {
        float ss = 0.f;
        const int cb = n0 + ai * 128 + wr * 64;
#pragma unroll
        for (int m = 0; m < 4; ++m) {
          const size_t off = (size_t)row * 1024 + cb + m * 16 + fq * 4;
          f32x4 v = *(const f32x4*)(xin + off);
          f32x4v a = acc[ai][bj][m][n];
          v.x += a.x; v.y += a.y; v.z += a.z; v.w += a.w;
          *(f32x4*)(xout + off) = v;
          ss += v.x * v.x + v.y * v.y + v.z * v.z + v.w * v.w;
          if (wr_norm) { u32x2 o2; o2.x = pack2(v.x, v.y); o2.y = pack2(v.z, v.w); *(u32x2*)(xb + off) = o2; }
        }
        ss += shx(ss, 16);
        ss += shx(ss, 32);
        if (wr_norm && fq == 0) ssp[(size_t)row * 16 + (cb >> 6)] = ss;
      }
    }
}
DI void wout_tile8(const WsPtrs& W, int layer, const float* xin, float* xout, int mt, int nt, unsigned char* smem) {
  const int m0 = mt * 256, n0 = nt * 256;
  f32x4v acc[2][2][4][2];
  gemm8(W.W + (size_t)layer * W_LAYER + W_OUT, 1024, W.MERGED, 1024, 1024, n0, m0, acc, smem);
  resid_store8(acc, xin, xout, W.XB2, W.SSB, m0, n0);
}
DI void ffn2_tile8(const WsPtrs& W, int layer, float* x, int mt, int nt, unsigned char* smem) {
  const int m0 = mt * 256, n0 = nt * 256;
  f32x4v acc[2][2][4][2];
  gemm8(W.W + (size_t)layer * W_LAYER + W_FF2, 4096, W.H1, 4096, 4096, n0, m0, acc, smem);
  resid_store8(acc, x, x, W.XB2, W.SSC, m0, n0);
}

DI void inproj_tile8(const Params& P, const WsPtrs& W, int layer, int mt, int nt, unsigned char* smem) {
  const int m0 = mt * 256, n0 = nt * 256;
  const u16* Wt = W.W + (size_t)layer * W_LAYER + W_IN;
  float* rs = (float*)(smem + RS_OFF);
  tile_rinv(W.SSA, layer == 0 ? 1 : 16, m0, rs);
  f32x4v acc[2][2][4][2];
  if (n0 >= O_BV && n0 < O_DQ) {
    gemm8(W.XB, 1024, Wt, 1024, 1024, m0, n0, acc, smem);
    const int tid2 = get_tid();
    const int wid = tid2 >> 6, lane = tid2 & 63, wr = wid >> 2, wc = wid & 3, fr = lane & 15, fq = lane >> 4;
    u16* vT = (n0 < O_DV) ? W.BVT : W.DVT;
    const int nrel0 = (n0 < O_DV) ? n0 - O_BV : n0 - O_DV;
#pragma unroll
    for (int ai = 0; ai < 2; ++ai)
#pragma unroll
      for (int m = 0; m < 4; ++m) {
        const int tl = ai * 128 + wr * 64 + m * 16 + fq * 4;
        const f32x4 sc = *(const f32x4*)(rs + tl);
        const int mg = m0 + tl, bl = mg >> 12, sp = vperm(mg & 4095);
#pragma unroll
        for (int bj = 0; bj < 2; ++bj)
#pragma unroll
          for (int n = 0; n < 2; ++n) {
            const int nrel = nrel0 + bj * 128 + wc * 32 + n * 16 + fr, hh = nrel >> 7, dv = nrel & 127;
            f32x4v a = acc[ai][bj][m][n];
            u32x2 o2; o2.x = pack2(a.x * sc.x, a.y * sc.y); o2.y = pack2(a.z * sc.z, a.w * sc.w);
            *(u32x2*)(vT + ((size_t)((bl * 8 + hh) * 128 + dv)) * 4096 + sp) = o2;
          }
      }
    return;
  }
  gemm8(Wt, 1024, W.XB, 1024, 1024, n0, m0, acc, smem);
  const int tid2 = get_tid();
  const int wid = tid2 >> 6, lane = tid2 & 63, wr = wid >> 2, wc = wid & 3, fr = lane & 15, fq = lane >> 4;
  const bool qsec = (n0 >= O_BQ && n0 < O_BV), rsec = (n0 >= O_DQ && n0 < O_DG);
#pragma unroll
  for (int bj = 0; bj < 2; ++bj)
#pragma unroll
    for (int n = 0; n < 2; ++n) {
      const int tl = bj * 128 + wc * 32 + n * 16 + fr;
      const float rv = rs[tl];
      const float pos = (float)((m0 + tl) & 4095);
      u16* rowp = W.Y + (size_t)(m0 + tl) * LDY;
#pragma unroll
      for (int ai = 0; ai < 2; ++ai) {
        const int cb = n0 + ai * 128 + wr * 64;
        f32x4v v[4];
#pragma unroll
        for (int m = 0; m < 4; ++m) { v[m] = acc[ai][bj][m][n]; v[m].x *= rv; v[m].y *= rv; v[m].z *= rv; v[m].w *= rv; }
        if (qsec) {
          const bool isq = cb < O_BK;
          const float* gp = (isq ? P.in[I_DQG] : P.in[I_DKG]) + layer * 64;
          float ss = 0.f;
#pragma unroll
          for (int m = 0; m < 4; ++m) ss += v[m].x * v[m].x + v[m].y * v[m].y + v[m].z * v[m].z + v[m].w * v[m].w;
          ss += shx(ss, 16);
          ss += shx(ss, 32);
          const float sc = rsqrtf(ss * (1.f / 64.f) + EPSV) * (isq ? 0.125f * LOG2E : 1.f);
#pragma unroll
          for (int m = 0; m < 4; ++m) {
            const f32x4 g4 = *(const f32x4*)(gp + m * 16 + fq * 4);
            v[m].x *= sc * g4.x; v[m].y *= sc * g4.y; v[m].z *= sc * g4.z; v[m].w *= sc * g4.w;
          }
          const f32x4 fr4 = *(const f32x4*)(W.rope + (fq & 1) * 4);
          float mine[4] = {v[0].x, v[0].y, v[0].z, v[0].w}, frq[4] = {fr4.x, fr4.y, fr4.z, fr4.w}, outv[4];
#pragma unroll
          for (int j = 0; j < 4; ++j) {
            float c, sn; rot_cs(pos, frq[j], c, sn);
            float oth = shx(mine[j], 32);
            outv[j] = (fq < 2) ? (mine[j] * c - oth * sn) : (mine[j] * c + oth * sn);
          }
          v[0].x = outv[0]; v[0].y = outv[1]; v[0].z = outv[2]; v[0].w = outv[3];
        } else if (rsec) {
          const float ksc = (cb < O_DK) ? 1.f : 0.125f;
#pragma unroll
          for (int m = 0; m < 2; ++m) {
            const f32x4 f4 = *(const f32x4*)(W.rope + 40 + m * 16 + fq * 4);
            float frq[4] = {f4.x, f4.y, f4.z, f4.w};
            float x1[4] = {v[m].x, v[m].y, v[m].z, v[m].w}, x2[4] = {v[m + 2].x, v[m + 2].y, v[m + 2].z, v[m + 2].w};
#pragma unroll
            for (int j = 0; j < 4; ++j) {
              float c, sn; rot_cs(pos, frq[j], c, sn);
              float a = (x1[j] * c - x2[j] * sn) * ksc, b = (x2[j] * c + x1[j] * sn) * ksc;
              x1[j] = a; x2[j] = b;
            }
            v[m].x = x1[0]; v[m].y = x1[1]; v[m].z = x1[2]; v[m].w = x1[3];
            v[m + 2].x = x2[0]; v[m + 2].y = x2[1]; v[m + 2].z = x2[2]; v[m + 2].w = x2[3];
          }
        }
#pragma unroll
        for (int m = 0; m < 4; ++m) {
          const int f = cb + m * 16 + fq * 4;
          if (f < O_END) {
            u32x2 o2; o2.x = pack2(v[m].x, v[m].y); o2.y = pack2(v[m].z, v[m].w);
            *(u32x2*)(rowp + f) = o2;
          }
        }
      }
    }
}

DI void branch_tile8(const Params& P, const WsPtrs& W, int layer, int mt, int nt, unsigned char* smem) {
  const int m0 = mt * 256, n0 = nt * 256;
#pragma unroll 1
  for (int jb = 0; jb < 4; ++jb) {
    f32x4v acc[2][2][4][2];
    gemm8(W.W + (size_t)layer * W_LAYER + W_BR + (size_t)jb * 1048576, 1024, W.YMIX + jb * 1024, 4096, 1024, n0, m0, acc, smem);
    const int tid2 = get_tid();
    const int wid = tid2 >> 6, lane = tid2 & 63, wr = wid >> 2, wc = wid & 3, fr = lane & 15, fq = lane >> 4;
    const float* gbp = P.in[I_GATEB] + layer * 4096 + jb * 1024;
#pragma unroll
    for (int bj = 0; bj < 2; ++bj)
#pragma unroll
      for (int n = 0; n < 2; ++n) {
        const int row = m0 + bj * 128 + wc * 32 + n * 16 + fr;
        const u16* gp = W.Y + (size_t)row * LDY + O_GT + jb * 1024;
        u16* mp = W.MERGED + (size_t)row * 1024;
#pragma unroll
        for (int ai = 0; ai < 2; ++ai)
#pragma unroll
          for (int m = 0; m < 4; ++m) {
            const int f = n0 + ai * 128 + wr * 64 + m * 16 + fq * 4;
            const u32x2 gv = *(const u32x2*)(gp + f);
            const f32x4 b4 = *(const f32x4*)(gbp + f);
            f32x4v a = acc[ai][bj][m][n];
            float v0 = sigmoidf_(bflo(gv.x) + b4.x) * a.x, v1 = sigmoidf_(bfhi(gv.x) + b4.y) * a.y;
            float v2 = sigmoidf_(bflo(gv.y) + b4.z) * a.z, v3 = sigmoidf_(bfhi(gv.y) + b4.w) * a.w;
            if (jb > 0) { const u32x2 pv = *(const u32x2*)(mp + f); v0 += bflo(pv.x); v1 += bfhi(pv.x); v2 += bflo(pv.y); v3 += bfhi(pv.y); }
            u32x2 o2; o2.x = pack2(v0, v1); o2.y = pack2(v2, v3);
            *(u32x2*)(mp + f) = o2;
          }
      }
  }
}

DI void mla_up_tile8(const WsPtrs& W, int layer, int item, int mtiles, unsigned char* smem) {
  const int tid = get_tid();
  const bool isq = item < mtiles * 6;
  int mt, nt;
  if (isq) { mt = item / 6; nt = item % 6; } else { int u = item - mtiles * 6; mt = u >> 3; nt = u & 7; }
  const int m0 = mt * 256, n0 = nt * 256;
  const int K = isq ? 384 : 256;
  const u16* A = W.Y + (isq ? O_CQ : O_CKV);
  const u16* Bt = W.W + (size_t)layer * W_LAYER + (isq ? W_UQ : W_UKV);
  float* rs = (float*)(smem + RS_OFF);
  __syncthreads();
  {
    int row = tid >> 1, half = tid & 1, kh = K >> 1;
    const u16* p = A + (size_t)(m0 + row) * LDY + half * kh;
    float ss = 0.f;
    for (int c = 0; c < kh; c += 8) {
      u32x4 v = *(const u32x4*)(p + c);
      float a;
      a = bflo(v.x); ss += a * a; a = bfhi(v.x); ss += a * a; a = bflo(v.y); ss += a * a; a = bfhi(v.y); ss += a * a;
      a = bflo(v.z); ss += a * a; a = bfhi(v.z); ss += a * a; a = bflo(v.w); ss += a * a; a = bfhi(v.w); ss += a * a;
    }
    ss += shx(ss, 1);
    if (half == 0) rs[row] = rsqrtf(ss / (float)K + EPSV);
  }
  f32x4v acc[2][2][4][2];
  if (!isq && nt >= 4) {
    gemm8(A, LDY, Bt, K, K, m0, n0, acc, smem);
    const int tid2 = get_tid();
    const int wid = tid2 >> 6, lane = tid2 & 63, wr = wid >> 2, wc = wid & 3, fr = lane & 15, fq = lane >> 4;
#pragma unroll
    for (int ai = 0; ai < 2; ++ai)
#pragma unroll
      for (int m = 0; m < 4; ++m) {
        const int tl = ai * 128 + wr * 64 + m * 16 + fq * 4;
        const f32x4 sc = *(const f32x4*)(rs + tl);
        const int mg = m0 + tl, bl = mg >> 12, sp = vperm(mg & 4095);
#pragma unroll
        for (int bj = 0; bj < 2; ++bj)
#pragma unroll
          for (int n = 0; n < 2; ++n) {
            const int nrel = (n0 - 1024) + bj * 128 + wc * 32 + n * 16 + fr, hh = nrel >> 7, dv = nrel & 127;
            f32x4v a = acc[ai][bj][m][n];
            u32x2 o2; o2.x = pack2(a.x * sc.x, a.y * sc.y); o2.y = pack2(a.z * sc.z, a.w * sc.w);
            *(u32x2*)(W.CVT + ((size_t)((bl * 8 + hh) * 128 + dv)) * 4096 + sp) = o2;
          }
      }
    return;
  }
  gemm8(Bt, K, A, LDY, K, n0, m0, acc, smem);
  const int tid2 = get_tid();
  const int wid = tid2 >> 6, lane = tid2 & 63, wr = wid >> 2, wc = wid & 3, fr = lane & 15, fq = lane >> 4;
#pragma unroll
  for (int bj = 0; bj < 2; ++bj)
#pragma unroll
    for (int n = 0; n < 2; ++n) {
      const int tl = bj * 128 + wc * 32 + n * 16 + fr;
      const float rv = rs[tl];
      u16* rowp = (isq ? W.QC : W.KC) + (size_t)(m0 + tl) * 1536;
#pragma unroll
      for (int ai = 0; ai < 2; ++ai)
#pragma unroll
        for (int m = 0; m < 4; ++m) {
          const int f = n0 + ai * 128 + wr * 64 + m * 16 + fq * 4;
          const int dstc = isq ? f : ((f >> 7) * 192 + (f & 127));
          f32x4v a = acc[ai][bj][m][n];
          u32x2 o2; o2.x = pack2(a.x * rv, a.y * rv); o2.y = pack2(a.z * rv, a.w * rv);
          *(u32x2*)(rowp + dstc) = o2;
        }
    }
}

DI void pp_tile8(const WsPtrs& W, int layer, int mt, int nt, unsigned char* smem) {
  const int m0 = mt * 256, n0 = nt * 256;
  f32x4v acc[2][2][4][2];
  gemm8(W.W + (size_t)layer * W_LAYER + W_PE, 256, W.PB, 256, 256, n0, m0, acc, smem);
  const int tid2 = get_tid();
  const int wid = tid2 >> 6, lane = tid2 & 63, wr = wid >> 2, wc = wid & 3, fr = lane & 15, fq = lane >> 4;
#pragma unroll
  for (int bj = 0; bj < 2; ++bj)
#pragma unroll
    for (int n = 0; n < 2; ++n) {
      u16* rowp = W.MERGED + (size_t)(m0 + bj * 128 + wc * 32 + n * 16 + fr) * 1024 + n0 + wr * 64 + fq * 4;
#pragma unroll
      for (int ai = 0; ai < 2; ++ai)
#pragma unroll
        for (int m = 0; m < 4; ++m) {
          f32x4v a = acc[ai][bj][m][n];
          u32x2 o2; o2.x = pack2(a.x, a.y); o2.y = pack2(a.z, a.w);
          *(u32x2*)(rowp + ai * 128 + m * 16) = o2;
        }
    }
}
DI void ple_tile8(const WsPtrs& W, int layer, float* x, int mt, int nt, unsigned char* smem, bool feed_next) {
  const int m0 = mt * 256, n0 = nt * 256;
  float* rs = (float*)(smem + RS_OFF);
  tile_rinv(W.SSC, 16, m0, rs);
  f32x4v acc[2][2][4][2];
  gemm8(W.W + (size_t)layer * W_LAYER + W_PG, 1024, W.XB2, 1024, 1024, n0, m0, acc, smem);
  {
    const int tid2 = get_tid();
    const int wid = tid2 >> 6, lane = tid2 & 63, wr = wid >> 2, wc = wid & 3, fr = lane & 15, fq = lane >> 4;
#pragma unroll
    for (int bj = 0; bj < 2; ++bj)
#pragma unroll
      for (int n = 0; n < 2; ++n) {
        const int tl = bj * 128 + wc * 32 + n * 16 + fr;
        const float rv = rs[tl];
        const u16* pp = W.MERGED + (size_t)(m0 + tl) * 1024 + n0 + wr * 64 + fq * 4;
#pragma unroll
        for (int ai = 0; ai < 2; ++ai)
#pragma unroll
          for (int m = 0; m < 4; ++m) {
            const u32x2 pv = *(const u32x2*)(pp + ai * 128 + m * 16);
            f32x4v a = acc[ai][bj][m][n];
            a.x = sigmoidf_(a.x * rv) * bflo(pv.x); a.y = sigmoidf_(a.y * rv) * bfhi(pv.x);
            a.z = sigmoidf_(a.z * rv) * bflo(pv.y); a.w = sigmoidf_(a.w * rv) * bfhi(pv.y);
            acc[ai][bj][m][n] = a;
          }
      }
  }
  resid_store8(acc, x, x, W.XB, W.SSA, m0, n0, feed_next);
}

DI void ffn1_tile8(const WsPtrs& W, int layer, int mt, int nt, unsigned char* smem) {
  const int m0 = mt * 256, n0 = nt * 256;
  float* rs = (float*)(smem + RS_OFF);
  tile_rinv(W.SSB, 16, m0, rs);
  f32x4v acc[2][2][4][2];
  gemm8(W.W + (size_t)layer * W_LAYER + W_FF1, 1024, W.XB2, 1024, 1024, n0, m0, acc, smem);
  const int tid2 = get_tid();
  const int wid = tid2 >> 6, lane = tid2 & 63, wr = wid >> 2, wc = wid & 3, fr = lane & 15, fq = lane >> 4;
#pragma unroll
  for (int bj = 0; bj < 2; ++bj)
#pragma unroll
    for (int n = 0; n < 2; ++n) {
      const int tl = bj * 128 + wc * 32 + n * 16 + fr;
      const float rv = rs[tl];
      u16* rowp = W.H1 + (size_t)(m0 + tl) * 4096 + n0 + wr * 64 + fq * 4;
#pragma unroll
      for (int ai = 0; ai < 2; ++ai)
#pragma unroll
        for (int m = 0; m < 4; ++m) {
          f32x4v v = acc[ai][bj][m][n];
          float a0 = fmaxf(v.x * rv, 0.f), a1 = fmaxf(v.y * rv, 0.f), a2 = fmaxf(v.z * rv, 0.f), a3 = fmaxf(v.w * rv, 0.f);
          u32x2 o2; o2.x = pack2(a0 * a0, a1 * a1); o2.y = pack2(a2 * a2, a3 * a3);
          *(u32x2*)(rowp + ai * 128 + m * 16) = o2;
        }
    }
}

DI void branch_tile(const Params& P, const WsPtrs& W, int layer, int mt, int nt, unsigned char* smem) {
  const int tid = get_tid(), lane = tid & 63, w = tid >> 6, r = lane & 31, h = lane >> 5, wm = w >> 1, wn = w & 1;
  const int m0 = mt * 256, n0 = nt * 128;
  const int mrow0 = m0 + 64 * wm + r, nw0 = n0 + 64 * wn;
  f32x16 tot[2][2];
  acc_zero<2>(tot);
#pragma unroll 1
  for (int j = 0; j < 4; ++j) {
    f32x16 acc[2][2];
    acc_zero<2>(acc);
    gemm_main<true, 2, false>(W.YMIX + j * 1024, 4096, W.W + (size_t)layer * W_LAYER + W_BR + (size_t)j * 1048576, 1024, 1024, m0, n0, acc, smem);
#pragma unroll
    for (int im = 0; im < 2; ++im) {
      const u16* gp = W.Y + (size_t)(mrow0 + 32 * im) * LDY + O_GT + j * 1024 + nw0;
      const float* gbp = P.in[I_GATEB] + layer * 4096 + j * 1024 + nw0;
#pragma unroll
      for (int jn = 0; jn < 2; ++jn)
#pragma unroll
        for (int g = 0; g < 4; ++g) {
          u32x2 gv = *(const u32x2*)(gp + 32 * jn + 8 * g + 4 * h);
          f32x4 b4 = *(const f32x4*)(gbp + 32 * jn + 8 * g + 4 * h);
          tot[im][jn][4 * g] += sigmoidf_(bflo(gv.x) + b4.x) * acc[im][jn][4 * g]; tot[im][jn][4 * g + 1] += sigmoidf_(bfhi(gv.x) + b4.y) * acc[im][jn][4 * g + 1];
          tot[im][jn][4 * g + 2] += sigmoidf_(bflo(gv.y) + b4.z) * acc[im][jn][4 * g + 2]; tot[im][jn][4 * g + 3] += sigmoidf_(bfhi(gv.y) + b4.w) * acc[im][jn][4 * g + 3];
        }
    }
  }
  store_sw_bf16<2>(tot, W.MERGED, 1024, mrow0, nw0, h, 1 << 30);
}

template <int NJ>
DI void resid_store(const f32x16 (&acc)[2][NJ], const float* xin, float* xout, int mrow0, int nw0, int h) {
#pragma unroll
  for (int im = 0; im < 2; ++im)
#pragma unroll
    for (int jn = 0; jn < NJ; ++jn)
#pragma unroll
      for (int g = 0; g < 4; ++g) {
        size_t off = (size_t)(mrow0 + 32 * im) * 1024 + nw0 + 32 * jn + 8 * g + 4 * h;
        f32x4 v = *(const f32x4*)(xin + off);
        v.x += acc[im][jn][4 * g]; v.y += acc[im][jn][4 * g + 1]; v.z += acc[im][jn][4 * g + 2]; v.w += acc[im][jn][4 * g + 3];
        *(f32x4*)(xout + off) = v;
      }
}

template <int NJ>
DI void resid_store_x(const f32x16 (&acc)[2][NJ], const float* xin, float* xout, u16* xb, float* ssp, int slot, int mrow0, int nw0, int h) {
#pragma unroll
  for (int im = 0; im < 2; ++im) {
    float ss = 0.f;
#pragma unroll
    for (int jn = 0; jn < NJ; ++jn)
#pragma unroll
      for (int g = 0; g < 4; ++g) {
        size_t off = (size_t)(mrow0 + 32 * im) * 1024 + nw0 + 32 * jn + 8 * g + 4 * h;
        f32x4 v = *(const f32x4*)(xin + off);
        v.x += acc[im][jn][4 * g]; v.y += acc[im][jn][4 * g + 1]; v.z += acc[im][jn][4 * g + 2]; v.w += acc[im][jn][4 * g + 3];
        *(f32x4*)(xout + off) = v;
        ss += v.x * v.x + v.y * v.y + v.z * v.z + v.w * v.w;
        u32x2 o; o.x = pack2(v.x, v.y); o.y = pack2(v.z, v.w);
        *(u32x2*)(xb + off) = o;
      }
    ss += shx(ss, 32);
    if (h == 0) ssp[(size_t)(mrow0 + 32 * im) * 16 + slot] = ss;
  }
}

DI void wout_tile(const WsPtrs& W, int layer, const float* xin, float* xout, int mt, int nt, unsigned char* smem) {
  const int lane = get_tid() & 63, w = get_tid() >> 6, r = lane & 31, h = lane >> 5, wm = w >> 1, wn = w & 1;
  const int m0 = mt * 256, n0 = nt * 256;
  f32x16 acc[2][4];
  acc_zero<4>(acc);
  gemm_main<true, 4, false>(W.MERGED, 1024, W.W + (size_t)layer * W_LAYER + W_OUT, 1024, 1024, m0, n0, acc, smem);
  resid_store_x<4>(acc, xin, xout, W.XB2, W.SSB, (n0 + 128 * wn) >> 7, m0 + 64 * wm + r, n0 + 128 * wn, h);
}
DI void ffn1_tile(const WsPtrs& W, int layer, int mt, int nt, unsigned char* smem) {
  const int lane = get_tid() & 63, w = get_tid() >> 6, r = lane & 31, h = lane >> 5, wm = w >> 1, wn = w & 1;
  const int m0 = mt * 256, n0 = nt * 256;
  f32x16 acc[2][4];
  acc_zero<4>(acc);
  float* rs = (float*)(smem + RS_OFF);
  tile_rinv(W.SSB, 8, m0, rs);
  gemm_main<true, 4, false>(W.XB2, 1024, W.W + (size_t)layer * W_LAYER + W_FF1, 1024, 1024, m0, n0, acc, smem);
  const int mrow0 = m0 + 64 * wm + r;
#pragma unroll
  for (int im = 0; im < 2; ++im) {
    float rv = rs[64 * wm + r + 32 * im];
#pragma unroll
    for (int jn = 0; jn < 4; ++jn)
#pragma unroll
      for (int e = 0; e < 16; ++e) { float v = fmaxf(acc[im][jn][e] * rv, 0.f); acc[im][jn][e] = v * v; }
  }
  store_sw_bf16<4>(acc, W.H1, 4096, mrow0, n0 + 128 * wn, h, 1 << 30);
}
DI void ffn2_tile(const WsPtrs& W, int layer, float* x, int mt, int nt, unsigned char* smem) {
  const int lane = get_tid() & 63, w = get_tid() >> 6, r = lane & 31, h = lane >> 5, wm = w >> 1, wn = w & 1;
  const int m0 = mt * 256, n0 = nt * 256;
  f32x16 acc[2][4];
  acc_zero<4>(acc);
  gemm_main<true, 4, false>(W.H1, 4096, W.W + (size_t)layer * W_LAYER + W_FF2, 4096, 4096, m0, n0, acc, smem);
  resid_store_x<4>(acc, x, x, W.XB2, W.SSC, (n0 + 128 * wn) >> 7, m0 + 64 * wm + r, n0 + 128 * wn, h);
}
DI void ple_tile(const WsPtrs& W, int layer, float* x, const float* pin, int mt, int nt, unsigned char* smem) {
  const int lane = get_tid() & 63, w = get_tid() >> 6, r = lane & 31, h = lane >> 5, wm = w >> 1, wn = w & 1;
  const int m0 = mt * 256, n0 = nt * 128;
  const int mrow0 = m0 + 64 * wm + r;
  f32x16 gt[2][2];
  acc_zero<2>(gt);
  float* rs = (float*)(smem + RS_OFF);
  tile_rinv(W.SSC, 16, m0, rs);
  gemm_main<true, 2, false>(W.XB2, 1024, W.W + (size_t)layer * W_LAYER + W_PG, 1024, 1024, m0, n0, gt, smem);
#pragma unroll
  for (int im = 0; im < 2; ++im) {
    float rv = rs[64 * wm + r + 32 * im];
#pragma unroll
    for (int jn = 0; jn < 2; ++jn)
#pragma unroll
      for (int e = 0; e < 16; ++e) gt[im][jn][e] = sigmoidf_(gt[im][jn][e] * rv);
  }
  f32x16 acc[2][2];
  acc_zero<2>(acc);
  gemm_main<true, 2, true>(pin, 256, W.W + (size_t)layer * W_LAYER + W_PE, 256, 256, m0, n0, acc, smem);
#pragma unroll
  for (int im = 0; im < 2; ++im)
#pragma unroll
    for (int jn = 0; jn < 2; ++jn)
#pragma unroll
      for (int e = 0; e < 16; ++e) acc[im][jn][e] *= gt[im][jn][e];
  resid_store_x<2>(acc, x, x, W.XB, W.SSA, (n0 + 64 * wn) >> 6, mrow0, n0 + 64 * wn, h);
}

DI void gsync(unsigned* bar, unsigned* s_target) {
  asm volatile("s_waitcnt vmcnt(0)" ::: "memory");
  __syncthreads();
  if (threadIdx.x == 0) {
    const unsigned target = *s_target + gridDim.x;
    *s_target = target;
    __builtin_amdgcn_fence(__ATOMIC_RELEASE, "agent");
    asm volatile("s_waitcnt vmcnt(0)" ::: "memory");
    __hip_atomic_fetch_add(bar, 1u, __ATOMIC_RELAXED, __HIP_MEMORY_SCOPE_AGENT);
    while (__hip_atomic_load(bar, __ATOMIC_RELAXED, __HIP_MEMORY_SCOPE_AGENT) < target) __builtin_amdgcn_s_sleep(1);
    __builtin_amdgcn_fence(__ATOMIC_ACQUIRE, "agent");
    asm volatile("s_waitcnt vmcnt(0)" ::: "memory");
  }
  __syncthreads();
}

#define XB_TMO      128
#define XB_XCNT(j)  (256  + 64 * (j))
#define XB_XSUB(j)  (1280 + 64 * (j))
#define XB_XGEN(j)  (2304 + 64 * (j))
#define XB_TOP      3328
#define XB_TOPGEN   3392
#define XB_SPIN_CAP (1u << 20)
#define LAS __attribute__((address_space(3)))
DI unsigned xb_ld(unsigned* p) { return __hip_atomic_load(p, __ATOMIC_RELAXED, __HIP_MEMORY_SCOPE_AGENT); }
DI unsigned xb_add(unsigned* p, unsigned v) { return __hip_atomic_fetch_add(p, v, __ATOMIC_RELAXED, __HIP_MEMORY_SCOPE_AGENT); }
DI unsigned xb_xcc_id() { return (unsigned)__builtin_amdgcn_s_getreg((3 << 11) | 20) & 0xFu; }
#define XB_SPIN(cond, bar) do { unsigned _sp = 0; while (cond) { __builtin_amdgcn_s_sleep(1); \
    if ((++_sp & 255u) == 0u) { if (xb_ld(&(bar)[XB_TMO])) break; if (_sp > XB_SPIN_CAP) { atomicAdd(&(bar)[XB_TMO], 1u); break; } } } } while (0)
DI void xcd_barrier_post(unsigned* bar) { if (threadIdx.x == 0) (void)xb_add(&bar[XB_XCNT(xb_xcc_id())], 1u); }
DI void xcd_barrier_complete(unsigned* bar, unsigned x, unsigned& nloc, unsigned& nx) {
  const unsigned G = gridDim.x * gridDim.y * gridDim.z;
  unsigned sum, cnt, mine, sp = 0u;
  for (;;) {
    sum = 0u; cnt = 0u; mine = 0u;
#pragma unroll
    for (unsigned j = 0; j < 16; ++j) { const unsigned c = xb_ld(&bar[XB_XCNT(j)]); sum += c; cnt += (c > 0u) ? 1u : 0u; mine = (j == x) ? c : mine; }
    if (sum == G) break;
    __builtin_amdgcn_s_sleep(1);
    if ((++sp & 255u) == 0u) { if (xb_ld(&bar[XB_TMO])) break; if (sp > XB_SPIN_CAP) { atomicAdd(&bar[XB_TMO], 1u); break; } }
  }
  nloc = mine > 0u ? mine : 1u; nx = cnt > 0u ? cnt : 1u;
}
DI void xcd_barrier(unsigned* bar, volatile LAS unsigned* st) {
  asm volatile("s_waitcnt vmcnt(0)" ::: "memory");
  __syncthreads();
  if (threadIdx.x == 0) {
    const unsigned x = xb_xcc_id();
    __builtin_amdgcn_s_waitcnt(0);
    unsigned nloc = st[0], nx = st[1];
    if (nloc == 0u) { xcd_barrier_complete(bar, x, nloc, nx); st[0] = nloc; st[1] = nx; }
    const unsigned old = xb_add(&bar[XB_XSUB(x)], 1u);
    const unsigned gen = old / nloc;
    if (old + 1u == (gen + 1u) * nloc) {
      __builtin_amdgcn_fence(__ATOMIC_RELEASE, "agent");
      asm volatile("s_waitcnt vmcnt(0)" ::: "memory");
      const unsigned og = xb_add(&bar[XB_TOP], 1u);
      const unsigned tg = og / nx;
      if (og + 1u == (tg + 1u) * nx) xb_add(&bar[XB_TOPGEN], 1u);
      else XB_SPIN(xb_ld(&bar[XB_TOPGEN]) == tg, bar);
      __builtin_amdgcn_fence(__ATOMIC_ACQUIRE, "agent");
      xb_add(&bar[XB_XGEN(x)], 1u);
      asm volatile("s_waitcnt vmcnt(0)" ::: "memory");
    } else {
      XB_SPIN(xb_ld(&bar[XB_XGEN(x)]) == gen, bar);
      __builtin_amdgcn_fence(__ATOMIC_ACQUIRE, "agent");
      asm volatile("s_waitcnt vmcnt(0)" ::: "memory");
    }
  }
  __syncthreads();
}

#ifndef MINW
#define MINW 2
#endif
__global__ void __launch_bounds__(NTHR, 2) hybrid_encoder_mega(Params P) {
  cg::grid_group grid = cg::this_grid();
  extern __shared__ __attribute__((aligned(16))) unsigned char smem[];
  __shared__ int s_item;
  __shared__ unsigned s_bar_target;
  __shared__ __attribute__((aligned(16))) unsigned xb_words[4];
  if (threadIdx.x == 0) { s_bar_target = 0u; xb_words[0] = 0u; xb_words[1] = 0u; xb_words[2] = 0u; xb_words[3] = 0u; }
  __syncthreads();
  const int G = P.G, TG = G * SEQ, mtiles = TG / 256;
#define WSP ws_ptrs(P.ws, launder_s(P.G))
  const int ngroups = NBATCH / G;

  if (PH(0)) phase_convert(P, WSP, smem);
  grid.sync();

  xcd_barrier_post(WSP.xbar);
  int phase_ctr = 0;
  for (int grp = 0; grp < ngroups; ++grp) {
    for (int layer = 0; layer < NLAYER; ++layer) {
      const size_t tok0 = (size_t)grp * TG;
      const float* xin = (layer == 0 ? P.in[I_X] : P.out) + tok0 * 1024;
      float* xo = P.out + tok0 * 1024;
      if (layer == 0 && grp == 0) { const WsPtrs W = WSP; phase_rowprep(xin, W.XB, W.SSA, TG); xcd_barrier(WSP.xbar, (volatile LAS unsigned*)xb_words); }
      for (int rep = 0; rep < DUP(2); ++rep)
      for (int t = blockIdx.x; t < mtiles * 51; t += gridDim.x) { int mt, nt; tile_map(t, mtiles, mt, nt); if (PH(2)) inproj_tile8(P, WSP, layer, mt, nt, smem); }
      xcd_barrier(WSP.xbar, (volatile LAS unsigned*)xb_words);
      {
        int* ctr3 = WSP.cnt + 32 + phase_ctr;
        const int total3 = mtiles * 14 + G * 128;
        while (true) {
          __syncthreads();
          if (get_tid() == 0) s_item = atomicAdd(ctr3, 1);
          __syncthreads();
          const int t = s_item;
          if (t >= total3) break;
          if (t < mtiles * 14) { if (PH(3)) mla_up_tile8(WSP, layer, t, mtiles, smem); } else ret_kv_item(WSP, t - mtiles * 14, smem);
        }
      }
      xcd_barrier(WSP.xbar, (volatile LAS unsigned*)xb_words);
      if (PH(4)) { ret_state_scan(WSP, G); mla_prep(P, WSP, layer, TG); p_convert(P.in[I_P] + ((size_t)layer * TT + tok0) * 256, WSP.PB, TG * 32); }
      xcd_barrier(WSP.xbar, (volatile LAS unsigned*)xb_words);
      {
        int* c8 = WSP.cnt + 64 + phase_ctr * 8; phase_ctr++;
        const int l_lru = G * 2, l_mla = G * 16, l_diff = G * 32, l_ret = G * 16;
        const int per = l_lru + l_mla + l_diff + l_ret;
        const int myx = (int)xb_xcc_id() & 7;
        for (int q8 = 0; q8 < 8; ++q8) {
          const int xq = (myx + q8) & 7;
          while (true) {
            __syncthreads();
            if (get_tid() == 0) s_item = atomicAdd(c8 + xq, 1);
            __syncthreads();
            const int j = s_item;
            if (j >= per) break;
            if (j < l_lru) { if (PH(5)) lru_item(P, WSP, layer, j * 8 + xq, smem); }
            else if (j < l_lru + l_mla) { const int u = j - l_lru; if (PH(6)) mla_attn_item(WSP, P.in[I_MQG] + layer * 192, P.in[I_MKG] + layer * 192, (((u >> 4) * 8 + xq) << 4) | (u & 15), smem); }
            else if (j < l_lru + l_mla + l_diff) { const int u = j - l_lru - l_mla; if (PH(8)) diff_attn_item(P, WSP, layer, (((u >> 5) * 8 + xq) << 5) | (u & 31), smem); }
            else { const int u = j - l_lru - l_mla - l_diff; if (PH(7)) ret_attn_item(P, WSP, layer, (((u >> 4) * 8 + xq) << 4) | (u & 15), smem); }
          }
        }
      }
      xcd_barrier(WSP.xbar, (volatile LAS unsigned*)xb_words);
      for (int t = blockIdx.x; t < mtiles * 4; t += gridDim.x) { int mt, nt; tile_map(t, mtiles, mt, nt); if (PH(9)) branch_tile8(P, WSP, layer, mt, nt, smem); }
      xcd_barrier(WSP.xbar, (volatile LAS unsigned*)xb_words);
      for (int t = blockIdx.x; t < mtiles * 4; t += gridDim.x) { int mt, nt; tile_map(t, mtiles, mt, nt); if (PH(10)) wout_tile8(WSP, layer, xin, xo, mt, nt, smem); }
      xcd_barrier(WSP.xbar, (volatile LAS unsigned*)xb_words);
      for (int rep = 0; rep < DUP(11); ++rep)
      for (int t = blockIdx.x; t < mtiles * 20; t += gridDim.x) { int mt, nt; if (t < mtiles * 16) { tile_map(t, mtiles, mt, nt); if (PH(11)) ffn1_tile8(WSP, layer, mt, nt, smem); } else { tile_map(t - mtiles * 16, mtiles, mt, nt); pp_tile8(WSP, layer, mt, nt, smem); } }
      xcd_barrier(WSP.xbar, (volatile LAS unsigned*)xb_words);
      for (int t = blockIdx.x; t < mtiles * 4; t += gridDim.x) { int mt, nt; tile_map(t, mtiles, mt, nt); if (PH(12)) ffn2_tile8(WSP, layer, xo, mt, nt, smem); }
      if (layer == NLAYER - 1 && grp + 1 < ngroups) {
        const WsPtrs W = WSP; phase_rowprep(P.in[I_X] + (tok0 + TG) * 1024, W.XB, W.SSA, TG); }
      xcd_barrier(WSP.xbar, (volatile LAS unsigned*)xb_words);
      const float* pin = P.in[I_P] + ((size_t)layer * TT + tok0) * 256;
      for (int t = blockIdx.x; t < mtiles * 4; t += gridDim.x) { int mt, nt; tile_map(t, mtiles, mt, nt); if (PH(13)) ple_tile8(WSP, layer, xo, mt, nt, smem, layer + 1 < NLAYER); }
      xcd_barrier(WSP.xbar, (volatile LAS unsigned*)xb_words);
    }
  }
}

extern "C" void kernel_launch(void* const* d_in, const int* in_sizes, int n_in, void* d_out, int out_size, void* d_ws,
                              size_t ws_size, hipStream_t stream) {
  static int grid_blocks = 0;
  if (!grid_blocks) {
    int dev = 0, cus = 0, per_cu = 0;
    hipGetDevice(&dev);
    hipDeviceGetAttribute(&cus, hipDeviceAttributeMultiprocessorCount, dev);
    hipFuncSetAttribute((const void*)hybrid_encoder_mega, hipFuncAttributeMaxDynamicSharedMemorySize, SMEM_BYTES);
    hipOccupancyMaxActiveBlocksPerMultiprocessor(&per_cu, hybrid_encoder_mega, NTHR, SMEM_BYTES);
    if (per_cu > 1) per_cu = 1;
    if (per_cu < 1) per_cu = 1;
    grid_blocks = cus * per_cu;
  }
  Params p{};
  for (int i = 0; i < 34; ++i) p.in[i] = (const float*)d_in[i];
  p.out = (float*)d_out;
  p.ws = (unsigned char*)d_ws;
  int G = 4;
  while (G > 1 && ws_need(G) > ws_size) G >>= 1;
  p.G = G;
  p.pad = 0;
  void* args[] = {&p};
  hipError_t e = hipLaunchCooperativeKernel((void*)hybrid_encoder_mega, dim3(grid_blocks), dim3(NTHR), args, SMEM_BYTES, stream);
  if (e != hipSuccess) fprintf(stderr, "cooperative launch failed: %s (grid %d)\n", hipGetErrorString(e), grid_blocks);
}
```
